# Optimizing an MI355X kernel written in HIP

```python
import jax, jax.numpy as jnp
from jax import lax
import numpy as np

D_MODEL = 2048
BATCH = 4
SEQ = 2048
DEPTH = 1
DEC_BATCH = 128
DEC_SEQ = 8
PAST_LEN = 8192
PAGE_SIZE = 128

HEAD_DIM = 64
N_Q_HEADS = 16
N_KV_HEADS = 4
Q_PER_KV = N_Q_HEADS // N_KV_HEADS
WINDOW = 128
ATTN_Q_WIDTH = N_Q_HEADS * HEAD_DIM
ATTN_KV_WIDTH = N_KV_HEADS * HEAD_DIM
CHUNK = 128
GMLP_GROUPS = 8
GMLP_GROUP_DIM = 128
GMLP_WIDTH = GMLP_GROUPS * GMLP_GROUP_DIM
D_FF = -(-8 * D_MODEL // (3 * 256)) * 256
IN_WIDTH = ATTN_Q_WIDTH + 2 * ATTN_KV_WIDTH + 2 * GMLP_WIDTH + 2 * D_MODEL
EPS = 1e-6
NEG = -1e30

kernel_name = "gated_parallel_swa_sink_chunk_gmlp_decoder_step"


def rms_norm(x, g):
    xf = x.astype(jnp.float32)
    y = xf * lax.rsqrt(jnp.mean(xf * xf, axis=-1, keepdims=True) + EPS)
    return (y * g.astype(jnp.float32)).astype(x.dtype)


def layer_norm_nobias(x, g):
    xf = x.astype(jnp.float32)
    xc = xf - jnp.mean(xf, axis=-1, keepdims=True)
    y = xc * lax.rsqrt(jnp.mean(xc * xc, axis=-1, keepdims=True) + EPS)
    return (y * g.astype(jnp.float32)).astype(x.dtype)


def split_in(z):
    o0 = ATTN_Q_WIDTH
    o1 = o0 + ATTN_KV_WIDTH
    o2 = o1 + ATTN_KV_WIDTH
    o3 = o2 + GMLP_WIDTH
    o4 = o3 + GMLP_WIDTH
    o5 = o4 + D_MODEL
    return (z[..., :o0], z[..., o0:o1], z[..., o1:o2], z[..., o2:o3],
            z[..., o3:o4], z[..., o4:o5], z[..., o5:])


def sink_softmax(scores, mask, sink):
    s = jnp.where(mask, scores, NEG)
    m = jnp.maximum(jnp.max(s, axis=-1, keepdims=True), sink)
    p = jnp.exp(s - m)
    return p / (jnp.sum(p, axis=-1, keepdims=True) + jnp.exp(sink - m))


def chunk_spatial_gate(u, v, w_s, b_s):
    B, L = u.shape[0], u.shape[1]
    vc = v.reshape(B, L // CHUNK, CHUNK, GMLP_GROUPS, GMLP_GROUP_DIM)
    w = w_s * jnp.tril(jnp.ones((CHUNK, CHUNK), w_s.dtype))[None]
    mixed = jnp.einsum('gts,bcsgd->bctgd', w, vc) + b_s.T[None, None, :, :, None]
    return u * mixed.reshape(B, L, GMLP_GROUPS, GMLP_GROUP_DIM)


def branch_inputs(x, norm1_g, w_in, gmlp_norm_g):
    h = rms_norm(x, norm1_g)
    q, k, v, u, gv, ga, gb = split_in(h @ w_in)
    B, L = x.shape[0], x.shape[1]
    q = q.reshape(B, L, N_KV_HEADS, Q_PER_KV, HEAD_DIM)
    k = k.reshape(B, L, N_KV_HEADS, HEAD_DIM)
    v = v.reshape(B, L, N_KV_HEADS, HEAD_DIM)
    u = jax.nn.gelu(u).reshape(B, L, GMLP_GROUPS, GMLP_GROUP_DIM)
    gv = layer_norm_nobias(jax.nn.gelu(gv), gmlp_norm_g).reshape(B, L, GMLP_GROUPS, GMLP_GROUP_DIM)
    return q, k, v, u, gv, ga, gb


def merge_and_ffn(x, attn, gmlp, ga, gb, w_pa, w_pb, w_o, norm2_g, w_ff_gate, w_ff_up, w_ff_down):
    mix = jax.nn.sigmoid(ga) * (gmlp @ w_pa) + jax.nn.sigmoid(gb) * (attn @ w_pb)
    x = x + mix @ w_o
    hh = rms_norm(x, norm2_g)
    return x + (jax.nn.silu(hh @ w_ff_gate) * (hh @ w_ff_up)) @ w_ff_down


def prompt_attention(q, k, v, sinks):
    B, S = q.shape[0], q.shape[1]
    nb = S // WINDOW
    qb = q.reshape(B, nb, WINDOW, N_KV_HEADS, Q_PER_KV, HEAD_DIM).astype(jnp.float32)
    kb = k.reshape(B, nb, WINDOW, N_KV_HEADS, HEAD_DIM)
    vb = v.reshape(B, nb, WINDOW, N_KV_HEADS, HEAD_DIM)
    kk = jnp.concatenate([jnp.concatenate([jnp.zeros_like(kb[:, :1]), kb[:, :-1]], 1), kb], 2)
    vv = jnp.concatenate([jnp.concatenate([jnp.zeros_like(vb[:, :1]), vb[:, :-1]], 1), vb], 2)
    scores = jnp.einsum('bnqhrd,bnkhd->bnhrqk', qb, kk.astype(jnp.float32)) * (HEAD_DIM ** -0.5)
    i = jnp.arange(WINDOW)[:, None]
    j = jnp.arange(2 * WINDOW)[None, :]
    diff = i + WINDOW - j
    c = jnp.arange(nb)[:, None, None]
    mask = (diff >= 0)[None] & (diff <= WINDOW)[None] & (c * WINDOW + j - WINDOW >= 0)
    sink = sinks.astype(jnp.float32).reshape(1, 1, N_KV_HEADS, Q_PER_KV, 1, 1)
    probs = sink_softmax(scores, mask[None, :, None, None], sink)
    out = jnp.einsum('bnhrqk,bnkhd->bnqhrd', probs.astype(v.dtype), vv)
    return out.reshape(B, S, ATTN_Q_WIDTH)


def sample_attention(q, k, v, cache_k, cache_v, sinks):
    B, T = q.shape[0], q.shape[1]
    wc = cache_k.shape[1]
    kk = jnp.concatenate([cache_k, k], 1)
    vv = jnp.concatenate([cache_v, v], 1)
    scores = jnp.einsum('bqhrd,bkhd->bhrqk', q.astype(jnp.float32), kk.astype(jnp.float32)) * (HEAD_DIM ** -0.5)
    i = jnp.arange(T)[:, None]
    j = jnp.arange(wc + T)[None, :]
    diff = wc + i - j
    mask = (diff >= 0) & (diff <= WINDOW)
    sink = sinks.astype(jnp.float32).reshape(1, N_KV_HEADS, Q_PER_KV, 1, 1)
    probs = sink_softmax(scores, mask, sink)
    out = jnp.einsum('bhrqk,bkhd->bqhrd', probs.astype(v.dtype), vv)
    return out.reshape(B, T, ATTN_Q_WIDTH), kk[:, -wc:], vv[:, -wc:]


def setup_inputs(seed: int = 0) -> dict:
    key = jax.random.key(seed)
    ks = jax.random.split(key, 20)
    f32 = jnp.float32
    n = lambda k, shape, s: jax.random.normal(k, shape, f32) * s
    cache_w = min(WINDOW, PAST_LEN)
    return {
        "x_prompt": n(ks[0], (BATCH, SEQ, D_MODEL), 1.0),
        "x_sample": n(ks[1], (DEC_BATCH, DEC_SEQ, D_MODEL), 1.0),
        "cache_k": n(ks[2], (DEPTH, DEC_BATCH, cache_w, N_KV_HEADS, HEAD_DIM), 1.0),
        "cache_v": n(ks[3], (DEPTH, DEC_BATCH, cache_w, N_KV_HEADS, HEAD_DIM), 1.0),
        "norm1_g": 1.0 + n(ks[4], (DEPTH, D_MODEL), 0.02),
        "w_in": n(ks[5], (DEPTH, D_MODEL, IN_WIDTH), D_MODEL ** -0.5),
        "gmlp_norm_g": 1.0 + n(ks[6], (DEPTH, GMLP_WIDTH), 0.02),
        "w_s": n(ks[7], (DEPTH, GMLP_GROUPS, CHUNK, CHUNK), CHUNK ** -0.5),
        "b_s": n(ks[8], (DEPTH, GMLP_GROUPS, CHUNK), 0.02),
        "sinks": n(ks[9], (DEPTH, N_Q_HEADS), 0.5),
        "w_pa": n(ks[10], (DEPTH, GMLP_WIDTH, D_MODEL), GMLP_WIDTH ** -0.5),
        "w_pb": n(ks[11], (DEPTH, ATTN_Q_WIDTH, D_MODEL), ATTN_Q_WIDTH ** -0.5),
        "w_o": n(ks[12], (DEPTH, D_MODEL, D_MODEL), D_MODEL ** -0.5),
        "norm2_g": 1.0 + n(ks[13], (DEPTH, D_MODEL), 0.02),
        "w_ff_gate": n(ks[14], (DEPTH, D_MODEL, D_FF), D_MODEL ** -0.5),
        "w_ff_up": n(ks[15], (DEPTH, D_MODEL, D_FF), D_MODEL ** -0.5),
        "w_ff_down": n(ks[16], (DEPTH, D_FF, D_MODEL), D_FF ** -0.5),
        "final_g": 1.0 + n(ks[17], (D_MODEL,), 0.02),
    }


def reference(x_prompt, x_sample, cache_k, cache_v, norm1_g, w_in, gmlp_norm_g, w_s, b_s, sinks,
              w_pa, w_pb, w_o, norm2_g, w_ff_gate, w_ff_up, w_ff_down, final_g):
    xp, xs = x_prompt, x_sample
    pk_list, pv_list, sk_list, sv_list, sg_list = [], [], [], [], []
    for l in range(DEPTH):
        B, S = xp.shape[0], xp.shape[1]
        q, k, v, u, gv, ga, gb = branch_inputs(xp, norm1_g[l], w_in[l], gmlp_norm_g[l])
        attn = prompt_attention(q, k, v, sinks[l])
        gm = chunk_spatial_gate(u, gv, w_s[l], b_s[l]).reshape(B, S, GMLP_WIDTH)
        xp = merge_and_ffn(xp, attn, gm, ga, gb, w_pa[l], w_pb[l], w_o[l], norm2_g[l],
                           w_ff_gate[l], w_ff_up[l], w_ff_down[l])
        pk_list.append(k[:, -WINDOW:])
        pv_list.append(v[:, -WINDOW:])

        Bd, T = xs.shape[0], xs.shape[1]
        q, k, v, u, gv, ga, gb = branch_inputs(xs, norm1_g[l], w_in[l], gmlp_norm_g[l])
        attn, k_win, v_win = sample_attention(q, k, v, cache_k[l], cache_v[l], sinks[l])
        pad = (-T) % CHUNK
        padw = ((0, 0), (0, pad), (0, 0), (0, 0))
        gm = chunk_spatial_gate(jnp.pad(u, padw), jnp.pad(gv, padw), w_s[l], b_s[l])[:, :T]
        xs = merge_and_ffn(xs, attn, gm.reshape(Bd, T, GMLP_WIDTH), ga, gb, w_pa[l], w_pb[l], w_o[l],
                           norm2_g[l], w_ff_gate[l], w_ff_up[l], w_ff_down[l])
        sk_list.append(k_win)
        sv_list.append(v_win)
        sg_list.append(gv)

    y_prompt = rms_norm(xp, final_g)
    y_sample = rms_norm(xs, final_g)
    prompt_k_win = jnp.stack(pk_list, 0)
    prompt_v_win = jnp.stack(pv_list, 0)
    sample_k_win = jnp.stack(sk_list, 0)
    sample_v_win = jnp.stack(sv_list, 0)
    sample_gmlp_v = jnp.stack(sg_list, 0)
    return (y_prompt, y_sample, prompt_k_win, prompt_v_win, sample_k_win, sample_v_win, sample_gmlp_v)
```

```cpp
#include <hip/hip_runtime.h>
#include <hip/hip_cooperative_groups.h>
#include <cstdio>
#include <cstdint>
namespace cg = cooperative_groups;


#define LAS __attribute__((address_space(3)))
typedef unsigned short bf16_t;
typedef short bf16x8 __attribute__((ext_vector_type(8)));
typedef short s16x4 __attribute__((ext_vector_type(4)));
typedef float f32x4 __attribute__((ext_vector_type(4)));
typedef float f32x2 __attribute__((ext_vector_type(2)));
typedef unsigned u32x4 __attribute__((ext_vector_type(4)));
typedef unsigned u32x2 __attribute__((ext_vector_type(2)));

constexpr int DM = 2048, NPROMPT = 8192, NSAMPLE = 1024, MROWS = NPROMPT + NSAMPLE;
constexpr int SEQ = 2048, NBATCH = 4, DECB = 128, DECT = 8;
constexpr int QW = 1024, KVW = 256, GW = 1024, DFF = 5632, INW = 7680;
constexpr float EPS = 1e-6f;
constexpr float LOG2E = 1.4426950408889634f;
constexpr float QSCALE = 0.125f * LOG2E;
constexpr float NEGBIG = -1e30f;

constexpr size_t O_Y = 0;
constexpr size_t O_PK = (size_t)MROWS * DM;
constexpr size_t O_PV = O_PK + 4 * 128 * 256;
constexpr size_t O_SK = O_PV + 4 * 128 * 256;
constexpr size_t O_SV = O_SK + (size_t)DECB * 128 * 256;
constexpr size_t O_SG = O_SV + (size_t)DECB * 128 * 256;

constexpr size_t MiB = 1u << 20;
constexpr size_t WS_WIN = 1 * MiB, WS_WPA = 31 * MiB, WS_WPB = 35 * MiB, WS_WO = 39 * MiB, WS_WGU = 47 * MiB, WS_WD = 91 * MiB;
constexpr size_t WS_STG = 113 * MiB, WS_SS2 = 115 * MiB, WS_SS3 = 117 * MiB;
constexpr size_t WS_A = 119 * MiB;
constexpr size_t WS_PART = WS_A;
constexpr size_t WS_H = WS_A, WS_XG = WS_A;
constexpr size_t WS_ATT = 218 * MiB, WS_GM = 236 * MiB;
constexpr size_t WS_B = 155 * MiB;
constexpr size_t WS_Q = WS_B, WS_K = WS_B + 18 * MiB, WS_V = WS_K + 4608 * 1024, WS_U = WS_B + 27 * MiB, WS_GV = WS_B + 45 * MiB, WS_MIX = WS_B;
constexpr size_t WS_ACT = WS_B;
constexpr size_t WS_END = 254 * MiB;

constexpr int NWAVES = 8;
constexpr int LDS_BYTES = 147456;
constexpr int XB_LDS_OFF = 139264;

typedef __bf16 bf16x2_t __attribute__((ext_vector_type(2)));
__device__ __forceinline__ unsigned cvt_pk_bf16(float lo, float hi) { const f32x2 v = {lo, hi}; const bf16x2_t b = __builtin_convertvector(v, bf16x2_t); return __builtin_bit_cast(unsigned, b); }
__device__ __forceinline__ float bf_lo(unsigned w) { return __uint_as_float(w << 16); }
__device__ __forceinline__ float bf_hi(unsigned w) { return __uint_as_float(w & 0xffff0000u); }
__device__ __forceinline__ float bf1(bf16_t b) { return __uint_as_float((unsigned)b << 16); }
__device__ __forceinline__ float fast_rcp(float x) { return __builtin_amdgcn_rcpf(x); }
__device__ __forceinline__ float fast_exp2(float x) { return __builtin_amdgcn_exp2f(x); }
__device__ __forceinline__ float sigmoid_f(float x) { return fast_rcp(1.0f + fast_exp2(-LOG2E * x)); }
__device__ __forceinline__ float gelu_tanh_f(float x) { const float t = x + 0.044715f * x * x * x; return x * fast_rcp(1.0f + fast_exp2(-2.3022081983f * t)); }
__device__ __forceinline__ float wave_sum(float v) {
#pragma unroll
    for (int o = 1; o < 64; o <<= 1) v += __shfl_xor(v, o);
    return v;
}

namespace pg8 {
constexpr int BM = 256, BK = 64, HALF = 128, HTB = HALF * BK * 2, STAGE_BYTES = 8 * HTB, NXCD = 8, WGM = 8;
__host__ __device__ __forceinline__ int lds_byte(int r, int c) { const int st = (r >> 4) * 2 + (c >> 5), rr = r & 15, cc = c & 31, ob = rr * 64 + cc * 2; return st * 1024 + (ob ^ (((ob >> 9) & 1) << 5)); }
__host__ __device__ __forceinline__ void stage_rc(int b, int& R, int& C) { const int st = b / 1024, sb = b % 1024, swz = sb ^ (((sb >> 9) & 1) << 5); R = (st >> 1) * 16 + swz / 64; C = (st & 1) * 32 + (swz % 64) / 2; }
__host__ __device__ __forceinline__ int perm32(int rho) { const int n = rho >> 4, i = rho & 15; return 8 * (i >> 2) + 4 * n + (i & 3); }

struct Unit { int pm, pn, sel, kofs, nkt; };
struct Gemm { const bf16_t* A0; const bf16_t* B0; const bf16_t* A1; const bf16_t* B1; int M, N, K; };

struct StaticOrder {
    int nM, nN, nwg, G, c;
    __device__ void init(int M, int N, int K, int G_, int c_) { nM = M / BM; nN = N / BM; nwg = nM * nN; G = G_; c = c_; nkt = K / BK; }
    int nkt;
    __device__ void tile(int wgid, Unit& u) const {
        const int nig = WGM * nN, gid = wgid / nig, fm = gid * WGM, gsz = (nM - fm) < WGM ? (nM - fm) : WGM;
        u.pm = fm + ((wgid % nig) % gsz); u.pn = (wgid % nig) / gsz; u.sel = 0; u.kofs = 0; u.nkt = nkt;
    }
    __device__ bool next(int i, Unit& u) const {
        const long L = (long)i * G + c; if (L >= nwg) return false;
        int wgid = (int)L; { const int q = nwg / NXCD, r = nwg % NXCD, xcd = wgid % NXCD, off = wgid / NXCD; wgid = (xcd < r ? xcd * (q + 1) : r * (q + 1) + (xcd - r) * q) + off; }
        tile(wgid, u); return true;
    }
};
struct P1Order {
    StaticOrder a, b; int lo, hi;
    __device__ bool next(int i, Unit& u) const {
        const int r = lo + i; if (r >= hi) return false;
        long L = (long)r * a.G + a.c;
        const StaticOrder& s = (L < a.nwg) ? a : b; if (L >= a.nwg) L -= a.nwg;
        if (L >= s.nwg) return false;
        int wgid = (int)L; { const int q = s.nwg / NXCD, rr = s.nwg % NXCD, xcd = wgid % NXCD, off = wgid / NXCD; wgid = (xcd < rr ? xcd * (q + 1) : rr * (q + 1) + (xcd - rr) * q) + off; }
        s.tile(wgid, u); if (&s == &b) u.pn += 14; return true;
    }
};
struct DualOrder {
    StaticOrder b;
    __device__ bool next(int i, Unit& u) const { if (!b.next(i >> 1, u)) return false; u.sel = i & 1; return true; }
};

struct Ph45Order {
    StaticOrder p4p, p4s, p5p, p5s, p4all, p5all; int sp; bool split;
    __device__ static int swz(const StaticOrder& s, long L) { const int w = (int)L, q = s.nwg / NXCD, r = s.nwg % NXCD, xcd = w % NXCD, off = w / NXCD; return (xcd < r ? xcd * (q + 1) : r * (q + 1) + (xcd - r) * q) + off; }
    __device__ bool next(int i, Unit& u) const {
        if (!split) { if (sp == 0) { const bool ok = p4all.next(i, u); u.sel = 1; return ok; } if (sp == 1) return false; return p5all.next(i, u); }
        const int c = p4p.c;
        if (sp == 0) { if (i) return false; p4p.tile(swz(p4p, c), u); u.sel = 1; return true; }
        if (sp == 1) {
            if (c < 32) { if (i) return false; p4s.tile(swz(p4s, c), u); u.pm += 32; u.sel = 1; return true; }
            if (i > 1) return false; p5p.tile(swz(p5p, (c - 32) + 224 * i), u); return true; }
        const long J = (long)i * 256 + c; if (J >= 1136) return false;
        if (J < 960) p5p.tile(swz(p5p, 448 + J), u); else { p5s.tile(swz(p5s, J - 960), u); u.pm += 32; }
        return true;
    }
};

struct SplitTailOrder {
    StaticOrder p, all; int pass; bool split;
    __device__ bool next(int i, Unit& u) const {
        if (!split) return pass == 0 ? all.next(i, u) : false;
        if (i) return false;
        if (pass == 0) { p.tile(Ph45Order::swz(p, p.c), u); return true; }
        if (p.c >= 128) return false;
        const int tl = (p.c & 7) * 4 + (p.c >> 5), sp = (p.c >> 3) & 3;
        u.pm = 32 + (tl & 3); u.pn = tl >> 2; u.sel = 1 + tl; u.nkt = p.nkt / 4; u.kofs = sp * (p.nkt / 4); return true;
    }
};
template <class Epi, class Sched, bool DUAL = false>
__device__ __forceinline__ void gemm_phase(LAS unsigned char* lds, const Gemm g, const Sched& S, const Epi& E) {
    const int tid = threadIdx.x, wid = __builtin_amdgcn_readfirstlane(tid >> 6), lane = tid & 63, wr = wid >> 2, wc = wid & 3, fr = lane & 15, fq = lane >> 4;
    const int K = g.K;
    unsigned voffA[2], voffB[2];
#pragma unroll
    for (int i = 0; i < 2; ++i) { int R, C; stage_rc(tid * 16 + i * 8192, R, C); const int Rb = (R & ~31) + perm32(R & 31);
        voffA[i] = (unsigned)(R * K + C) * 2u; voffB[i] = (unsigned)(Rb * K + C) * 2u; }
    const size_t kstep = (size_t)(BK * 2);
    const size_t hstep = (size_t)HALF * K * 2;
    const size_t tstep = 2 * hstep;
    const unsigned ldsw = (unsigned)wid * 1024u;
    const int aoff = lds_byte(wr * 64 + fr, fq * 8), boff = lds_byte(wc * 32 + fr, fq * 8);
#define PG8_SA(b, h) (((b) * 2 + (h)) * HTB)
#define PG8_SB(b, h) ((4 + (b) * 2 + (h)) * HTB)
#define PG8_STAGE(bufoff, gbase, voff) do { _Pragma("unroll") for (int _i = 0; _i < 2; ++_i) \
        __builtin_amdgcn_global_load_lds((const unsigned*)((const char*)(gbase) + (voff)[_i]), (LAS unsigned*)(lds + (bufoff) + ldsw + _i * 8192), 16, 0, 0); } while (0)
#define PG8_LDA(dst, b, h) do { _Pragma("unroll") for (int m = 0; m < 4; ++m) _Pragma("unroll") for (int k = 0; k < 2; ++k) dst[m][k] = *(const LAS bf16x8*)(lds + PG8_SA(b, h) + aoff + m * 2048 + k * 1024); } while (0)
#define PG8_LDB(dst, b, h) do { _Pragma("unroll") for (int n = 0; n < 2; ++n) _Pragma("unroll") for (int k = 0; k < 2; ++k) dst[n][k] = *(const LAS bf16x8*)(lds + PG8_SB(b, h) + boff + n * 2048 + k * 1024); } while (0)
#define PG8_MMA(ai, bj, At, Bt) do { _Pragma("unroll") for (int m = 0; m < 4; ++m) _Pragma("unroll") for (int n = 0; n < 2; ++n) _Pragma("unroll") for (int k = 0; k < 2; ++k) \
        acc[ai][bj][m][n] = __builtin_amdgcn_mfma_f32_16x16x32_bf16(Bt[n][k], At[m][k], acc[ai][bj][m][n], 0, 0, 0); } while (0)
#define PG8_HI __builtin_amdgcn_s_setprio(1)
#define PG8_LO __builtin_amdgcn_s_setprio(0)
#define PG8_WAIT_V(n) asm volatile("s_waitcnt vmcnt(" #n ")" ::: "memory")
#define PG8_WAIT_L(n) asm volatile("s_waitcnt lgkmcnt(" #n ")" ::: "memory")
#define PG8_BAR __builtin_amdgcn_s_barrier()
#define PG8_SCHED __builtin_amdgcn_sched_barrier(0)
    Unit cur, nxt; int ui = 0;
    if (!S.next(0, cur)) return;
    f32x4 acc[2][2][4][2];
    E.init_acc(acc, cur, wr, wc, fr, fq);
    bf16x8 At[4][2], B0[2][2], B1[2][2];
    const char* cA = (const char*)((DUAL && cur.sel) ? g.A1 : g.A0) + (size_t)cur.pm * tstep + (size_t)cur.kofs * kstep; const char* cB = (const char*)((DUAL && cur.sel) ? g.B1 : g.B0) + (size_t)cur.pn * tstep + (size_t)cur.kofs * kstep;
    PG8_STAGE(PG8_SB(0, 0), cB, voffB); PG8_STAGE(PG8_SB(0, 1), cB + hstep, voffB); PG8_STAGE(PG8_SA(0, 0), cA, voffA); PG8_STAGE(PG8_SA(0, 1), cA + hstep, voffA);
    if (wr == 1) PG8_BAR;
    PG8_WAIT_V(2); PG8_BAR;
    PG8_STAGE(PG8_SB(1, 0), cB + kstep, voffB); PG8_STAGE(PG8_SA(1, 0), cA + kstep, voffA); PG8_STAGE(PG8_SB(1, 1), cB + hstep + kstep, voffB);
    PG8_WAIT_V(6); PG8_BAR;
    for (;;) {
        const bool has_next = S.next(ui + 1, nxt);
        const char* nA = has_next ? (const char*)((DUAL && nxt.sel) ? g.A1 : g.A0) + (size_t)nxt.pm * tstep + (size_t)nxt.kofs * kstep : cA; const char* nB = has_next ? (const char*)((DUAL && nxt.sel) ? g.B1 : g.B0) + (size_t)nxt.pn * tstep + (size_t)nxt.kofs * kstep : cB;
        const int nt = cur.nkt;
        for (int t = 0; t < nt; t += 2) {
            const bool last = (t == nt - 2);
            const char* a1 = cA + (size_t)(t + 1) * kstep;
            const char* a2 = last ? nA : cA + (size_t)(t + 2) * kstep; const char* b2 = last ? nB : cB + (size_t)(t + 2) * kstep;
            const char* a3 = a2 + kstep; const char* b3 = b2 + kstep;
            PG8_LDB(B0, 0, 0); PG8_LDB(B1, 0, 1); PG8_SCHED; PG8_LDA(At, 0, 0); PG8_STAGE(PG8_SA(1, 1), a1 + hstep, voffA);
            PG8_HI; PG8_WAIT_V(8); PG8_WAIT_L(0); PG8_BAR; PG8_MMA(0, 0, At, B0); PG8_MMA(0, 1, At, B1); PG8_LO; PG8_BAR; PG8_SCHED;
            PG8_LDA(At, 0, 1); PG8_STAGE(PG8_SB(0, 0), b2, voffB); PG8_STAGE(PG8_SB(0, 1), b2 + hstep, voffB); PG8_STAGE(PG8_SA(0, 0), a2, voffA);
            PG8_HI; PG8_WAIT_V(8); PG8_WAIT_L(0); PG8_BAR; PG8_MMA(1, 0, At, B0); PG8_MMA(1, 1, At, B1); PG8_LO; PG8_BAR; PG8_SCHED;
            PG8_LDB(B0, 1, 0); PG8_LDB(B1, 1, 1); PG8_SCHED; PG8_LDA(At, 1, 0); PG8_STAGE(PG8_SA(0, 1), a2 + hstep, voffA);
            PG8_HI; PG8_WAIT_V(8); PG8_WAIT_L(0); PG8_BAR; PG8_MMA(0, 0, At, B0); PG8_MMA(0, 1, At, B1); PG8_LO; PG8_BAR; PG8_SCHED;
            PG8_LDA(At, 1, 1); PG8_STAGE(PG8_SB(1, 0), b3, voffB); PG8_STAGE(PG8_SB(1, 1), b3 + hstep, voffB); PG8_STAGE(PG8_SA(1, 0), a3, voffA);
            PG8_HI; PG8_WAIT_V(8); PG8_WAIT_L(0); PG8_BAR; PG8_MMA(1, 0, At, B0); PG8_MMA(1, 1, At, B1); PG8_LO; PG8_BAR; PG8_SCHED;
        }
        if (wr == 0) PG8_BAR;
        { int fr_e = fr, fq_e = fq; asm volatile("" : "+v"(fr_e), "+v"(fq_e));
          E(acc, cur, wr, wc, fr_e, fq_e); }
        if (!has_next) break;
        if (!E.keep(cur)) { int fr_i = fr, fq_i = fq; asm volatile("" : "+v"(fr_i), "+v"(fq_i)); E.init_acc(acc, nxt, wr, wc, fr_i, fq_i); }
        cur = nxt; cA = nA; cB = nB; ++ui;
        if (wr == 1) PG8_BAR;
    }
    PG8_WAIT_V(0);
    PG8_BAR;
#undef PG8_SA
#undef PG8_SB
#undef PG8_STAGE
#undef PG8_LDA
#undef PG8_LDB
#undef PG8_MMA
#undef PG8_HI
#undef PG8_LO
#undef PG8_WAIT_V
#undef PG8_WAIT_L
#undef PG8_BAR
#undef PG8_SCHED
}
}

typedef f32x4 (&AccRef)[2][2][4][2];

__device__ __forceinline__ void acc_zero(AccRef acc) {
#pragma unroll
    for (int a = 0; a < 2; ++a)
#pragma unroll
        for (int b = 0; b < 2; ++b)
#pragma unroll
            for (int m = 0; m < 4; ++m)
#pragma unroll
                for (int n = 0; n < 2; ++n) acc[a][b][m][n] = (f32x4){0.f, 0.f, 0.f, 0.f};
}
__device__ __forceinline__ void acc_load(AccRef acc, const float* base, int rowt, int col0) {
#pragma unroll
    for (int ai = 0; ai < 2; ++ai)
#pragma unroll
        for (int m = 0; m < 4; ++m) { const float* rp = base + (size_t)(rowt + ai * 128 + m * 16) * DM + col0;
#pragma unroll
            for (int bj = 0; bj < 2; ++bj) { acc[ai][bj][m][0] = *(const f32x4*)(rp + bj * 128); acc[ai][bj][m][1] = *(const f32x4*)(rp + bj * 128 + 4); } }
}
template <int ACT>
__device__ __forceinline__ f32x4 act4(f32x4 v) {
    if (ACT == 1) return v * QSCALE;
    if (ACT == 2) return (f32x4){gelu_tanh_f(v[0]), gelu_tanh_f(v[1]), gelu_tanh_f(v[2]), gelu_tanh_f(v[3])};
    if (ACT == 3) return (f32x4){sigmoid_f(v[0]), sigmoid_f(v[1]), sigmoid_f(v[2]), sigmoid_f(v[3])};
    return v;
}
#define EPI_PIN(ai, m) f32x4 aq[2][2] = {{acc[ai][0][m][0], acc[ai][0][m][1]}, {acc[ai][1][m][0], acc[ai][1][m][1]}}; \
    asm volatile("" : "+v"(aq[0][0]), "+v"(aq[0][1]), "+v"(aq[1][0]), "+v"(aq[1][1]) :: "memory")
template <int ACT>
__device__ __forceinline__ void epi_store_bf16(AccRef acc, bf16_t* base, int ld, int rowt, int cw) {
#pragma unroll
    for (int ai = 0; ai < 2; ++ai)
#pragma unroll
        for (int m = 0; m < 4; ++m) { EPI_PIN(ai, m); bf16_t* rowp = base + (size_t)(rowt + ai * 128 + m * 16) * ld + cw;
#pragma unroll
            for (int bj = 0; bj < 2; ++bj) { const f32x4 v0 = act4<ACT>(aq[bj][0]), v1 = act4<ACT>(aq[bj][1]);
                u32x4 w; w.x = cvt_pk_bf16(v0[0], v0[1]); w.y = cvt_pk_bf16(v0[2], v0[3]); w.z = cvt_pk_bf16(v1[0], v1[1]); w.w = cvt_pk_bf16(v1[2], v1[3]);
                *(u32x4*)(rowp + bj * 128) = w; } }
}

struct Epi1 {
    bf16_t *Q, *Kb, *Vb, *U, *GV, *SA, *SB; float* stg; float* out;
    __device__ __forceinline__ void init_acc(AccRef acc, const pg8::Unit&, int, int, int, int) const { acc_zero(acc); }
    __device__ __forceinline__ bool keep(const pg8::Unit&) const { return false; }
    __device__ __forceinline__ void operator()(AccRef acc, const pg8::Unit& u, int wr, int wc, int fr, int fq) const {
        const int pn = u.pn, rowt = u.pm * 256 + wr * 64 + fr, cw = wc * 32 + 8 * fq;
        if (pn < 4) { epi_store_bf16<1>(acc, Q + pn * 256, QW, rowt, cw); }
        else if (pn < 6) {
            bf16_t* kb = (pn == 4) ? Kb : Vb;
            epi_store_bf16<0>(acc, kb, KVW, rowt, cw);
            if (u.pm >= 32) {
                float* ob = out + (pn == 4 ? O_SK : O_SV);
#pragma unroll
                for (int ai = 0; ai < 2; ++ai)
#pragma unroll
                    for (int m = 0; m < 4; ++m) { EPI_PIN(ai, m); const int r = rowt + ai * 128 + m * 16 - NPROMPT; const int sb = r >> 3, t = r & 7;
                        float* rowp = ob + ((size_t)sb * 128 + 120 + t) * 256 + cw;
#pragma unroll
                        for (int bj = 0; bj < 2; ++bj) { *(f32x4*)(rowp + bj * 128) = aq[bj][0]; *(f32x4*)(rowp + bj * 128 + 4) = aq[bj][1]; } }
            } else if ((u.pm & 7) == 7) {
                float* ob = out + (pn == 4 ? O_PK : O_PV);
#pragma unroll
                for (int m = 0; m < 4; ++m) { EPI_PIN(1, m); const int tw = wr * 64 + m * 16 + fr; float* rowp = ob + ((size_t)(u.pm >> 3) * 128 + tw) * 256 + cw;
#pragma unroll
                    for (int bj = 0; bj < 2; ++bj) { *(f32x4*)(rowp + bj * 128) = aq[bj][0]; *(f32x4*)(rowp + bj * 128 + 4) = aq[bj][1]; } }
            }
        }
        else if (pn < 10) { epi_store_bf16<2>(acc, U + (pn - 6) * 256, GW, rowt, cw); }
        else if (pn < 14) {
            bf16_t* base = GV + (pn - 10) * 256;
#pragma unroll
            for (int ai = 0; ai < 2; ++ai)
#pragma unroll
                for (int m = 0; m < 4; ++m) { EPI_PIN(ai, m); const int row = rowt + ai * 128 + m * 16; bf16_t* rowp = base + (size_t)row * GW + cw; float s = 0.f, q = 0.f;
#pragma unroll
                    for (int bj = 0; bj < 2; ++bj) { const f32x4 v0 = act4<2>(aq[bj][0]), v1 = act4<2>(aq[bj][1]);
                        s += (v0[0] + v0[1]) + (v0[2] + v0[3]) + (v1[0] + v1[1]) + (v1[2] + v1[3]);
                        q += (v0[0] * v0[0] + v0[1] * v0[1]) + (v0[2] * v0[2] + v0[3] * v0[3]) + (v1[0] * v1[0] + v1[1] * v1[1]) + (v1[2] * v1[2] + v1[3] * v1[3]);
                        u32x4 w; w.x = cvt_pk_bf16(v0[0], v0[1]); w.y = cvt_pk_bf16(v0[2], v0[3]); w.z = cvt_pk_bf16(v1[0], v1[1]); w.w = cvt_pk_bf16(v1[2], v1[3]);
                        *(u32x4*)(rowp + bj * 128) = w; }
                    s += __shfl_xor(s, 16); s += __shfl_xor(s, 32); q += __shfl_xor(q, 16); q += __shfl_xor(q, 32);
                    if (fq == 0) *(f32x2*)(stg + (size_t)row * 32 + ((pn - 10) * 4 + wc) * 2) = (f32x2){s, q}; }
        }
        else if (pn < 22) { epi_store_bf16<3>(acc, SA + (pn - 14) * 256, DM, rowt, cw); }
        else { epi_store_bf16<3>(acc, SB + (pn - 22) * 256, DM, rowt, cw); }
    }
};

struct Epi3 {
    const bf16_t *SA, *SB; bf16_t *MIXP, *MIXS;
    __device__ __forceinline__ void init_acc(AccRef acc, const pg8::Unit&, int, int, int, int) const { acc_zero(acc); }
    __device__ __forceinline__ bool keep(const pg8::Unit& u) const { return u.sel == 0; }
    __device__ __forceinline__ void operator()(AccRef acc, const pg8::Unit& u, int wr, int wc, int fr, int fq) const {
        const int rowt = u.pm * 256 + wr * 64 + fr, col0 = u.pn * 256 + wc * 32 + 8 * fq;
        bf16_t* MIX = (u.pm < 32) ? MIXP : MIXS;
#pragma unroll
        for (int ai = 0; ai < 2; ++ai) {
            u32x4 bw[4][2], aw[4][2];
#pragma unroll
            for (int m = 0; m < 4; ++m) { const size_t off = (size_t)(rowt + ai * 128 + m * 16) * DM + col0;
#pragma unroll
                for (int bj = 0; bj < 2; ++bj) { bw[m][bj] = *(const u32x4*)(SB + off + bj * 128); if (u.sel == 0) aw[m][bj] = *(const u32x4*)(SA + off + bj * 128); } }
#pragma unroll
            for (int m = 0; m < 4; ++m) { const size_t off = (size_t)(rowt + ai * 128 + m * 16) * DM + col0;
                asm volatile("" : "+v"(acc[ai][0][m][0]), "+v"(acc[ai][0][m][1]), "+v"(acc[ai][1][m][0]), "+v"(acc[ai][1][m][1]));
#pragma unroll
                for (int bj = 0; bj < 2; ++bj) { const u32x4 b4 = bw[m][bj];
                    f32x4 b0 = (f32x4){bf_lo(b4.x), bf_hi(b4.x), bf_lo(b4.y), bf_hi(b4.y)}, b1 = (f32x4){bf_lo(b4.z), bf_hi(b4.z), bf_lo(b4.w), bf_hi(b4.w)};
#pragma unroll
                    for (int j = 0; j < 4; ++j) { b0[j] = fmaxf(b0[j], 1e-20f); b1[j] = fmaxf(b1[j], 1e-20f); }
                    if (u.sel == 0) { const u32x4 a4 = aw[m][bj];
                        const f32x4 a0 = (f32x4){bf_lo(a4.x), bf_hi(a4.x), bf_lo(a4.y), bf_hi(a4.y)}, a1 = (f32x4){bf_lo(a4.z), bf_hi(a4.z), bf_lo(a4.w), bf_hi(a4.w)};
#pragma unroll
                        for (int j = 0; j < 4; ++j) { acc[ai][bj][m][0][j] *= a0[j] * fast_rcp(b0[j]); acc[ai][bj][m][1][j] *= a1[j] * fast_rcp(b1[j]); } }
                    else { const f32x4 v0 = b0 * acc[ai][bj][m][0], v1 = b1 * acc[ai][bj][m][1];
                        u32x4 w; w.x = cvt_pk_bf16(v0[0], v0[1]); w.y = cvt_pk_bf16(v0[2], v0[3]); w.z = cvt_pk_bf16(v1[0], v1[1]); w.w = cvt_pk_bf16(v1[2], v1[3]);
                        *(u32x4*)(MIX + off + bj * 128) = w; } }
                asm volatile("" : "+v"(acc[ai][0][m][0]), "+v"(acc[ai][0][m][1]), "+v"(acc[ai][1][m][0]), "+v"(acc[ai][1][m][1])); }
            asm volatile("" ::: "memory");
        }
    }
};

struct Epi4 {
    const float *xp, *xs, *g2; float* X1; bf16_t* XG; float* ss2;
    __device__ __forceinline__ void init_acc(AccRef acc, const pg8::Unit& u, int wr, int wc, int fr, int fq) const {
        acc_load(acc, (u.pm < 32) ? xp : (xs - (size_t)NPROMPT * DM), u.pm * 256 + wr * 64 + fr, u.pn * 256 + wc * 32 + 8 * fq); }
    __device__ __forceinline__ bool keep(const pg8::Unit&) const { return false; }
    __device__ __forceinline__ void operator()(AccRef acc, const pg8::Unit& u, int wr, int wc, int fr, int fq) const {
        const int rowt = u.pm * 256 + wr * 64 + fr, col0 = u.pn * 256 + wc * 32 + 8 * fq;
#pragma unroll
        for (int ai = 0; ai < 2; ++ai)
#pragma unroll
            for (int m = 0; m < 4; ++m) { EPI_PIN(ai, m); const int row = rowt + ai * 128 + m * 16; const size_t off = (size_t)row * DM + col0; float q = 0.f;
                f32x4 gv[2][2];
#pragma unroll
                for (int bj = 0; bj < 2; ++bj) { gv[bj][0] = *(const f32x4*)(g2 + col0 + bj * 128); gv[bj][1] = *(const f32x4*)(g2 + col0 + bj * 128 + 4); }
#pragma unroll
                for (int bj = 0; bj < 2; ++bj) { const f32x4 v0 = aq[bj][0], v1 = aq[bj][1];
                    *(f32x4*)(X1 + off + bj * 128) = v0; *(f32x4*)(X1 + off + bj * 128 + 4) = v1;
                    q += (v0[0] * v0[0] + v0[1] * v0[1]) + (v0[2] * v0[2] + v0[3] * v0[3]) + (v1[0] * v1[0] + v1[1] * v1[1]) + (v1[2] * v1[2] + v1[3] * v1[3]);
                    const f32x4 h0 = v0 * gv[bj][0], h1 = v1 * gv[bj][1];
                    u32x4 w; w.x = cvt_pk_bf16(h0[0], h0[1]); w.y = cvt_pk_bf16(h0[2], h0[3]); w.z = cvt_pk_bf16(h1[0], h1[1]); w.w = cvt_pk_bf16(h1[2], h1[3]);
                    *(u32x4*)(XG + off + bj * 128) = w; }
                q += __shfl_xor(q, 16); q += __shfl_xor(q, 32);
                if (fq == 0) ss2[(size_t)row * 32 + u.pn * 4 + wc] = q; }
    }
};

struct Epi5 {
    const float* ss2; bf16_t* ACT;
    __device__ __forceinline__ void init_acc(AccRef acc, const pg8::Unit&, int, int, int, int) const { acc_zero(acc); }
    __device__ __forceinline__ bool keep(const pg8::Unit&) const { return false; }
    __device__ __forceinline__ void operator()(AccRef acc, const pg8::Unit& u, int wr, int wc, int fr, int fq) const {
        const int rowt = u.pm * 256 + wr * 64 + fr, col0 = u.pn * 128 + wc * 32 + 8 * fq;
        float rs[8]; f32x4 pp[8][2];
#pragma unroll
        for (int r = 0; r < 8; ++r) { const float* sp = ss2 + (size_t)(rowt + (r >> 2) * 128 + (r & 3) * 16) * 32 + fq * 8; pp[r][0] = *(const f32x4*)sp; pp[r][1] = *(const f32x4*)(sp + 4); }
#pragma unroll
        for (int r = 0; r < 8; ++r) { float sm = (pp[r][0][0] + pp[r][0][1]) + (pp[r][0][2] + pp[r][0][3]) + (pp[r][1][0] + pp[r][1][1]) + (pp[r][1][2] + pp[r][1][3]);
            sm += __shfl_xor(sm, 16); sm += __shfl_xor(sm, 32); rs[r] = __builtin_amdgcn_rsqf(sm * (1.0f / DM) + EPS); }
        asm volatile("" ::: "memory");
#pragma unroll
        for (int ai = 0; ai < 2; ++ai)
#pragma unroll
            for (int m = 0; m < 4; ++m) { EPI_PIN(ai, m); const int row = rowt + ai * 128 + m * 16; const float rstd = rs[ai * 4 + m];
                f32x4 o[2];
#pragma unroll
                for (int n = 0; n < 2; ++n) { const f32x4 gt = aq[0][n] * rstd, up = aq[1][n] * rstd;
#pragma unroll
                    for (int j = 0; j < 4; ++j) o[n][j] = gt[j] * sigmoid_f(gt[j]) * up[j]; }
                u32x4 w; w.x = cvt_pk_bf16(o[0][0], o[0][1]); w.y = cvt_pk_bf16(o[0][2], o[0][3]); w.z = cvt_pk_bf16(o[1][0], o[1][1]); w.w = cvt_pk_bf16(o[1][2], o[1][3]);
                *(u32x4*)(ACT + (size_t)row * DFF + col0) = w; }
    }
};

struct Epi45 {
    Epi4 e4; Epi5 e5;
    __device__ __forceinline__ void init_acc(AccRef acc, const pg8::Unit& u, int wr, int wc, int fr, int fq) const { if (u.sel) e4.init_acc(acc, u, wr, wc, fr, fq); else acc_zero(acc); }
    __device__ __forceinline__ bool keep(const pg8::Unit&) const { return false; }
    __device__ __forceinline__ void operator()(AccRef acc, const pg8::Unit& u, int wr, int wc, int fr, int fq) const { if (u.sel) e4(acc, u, wr, wc, fr, fq); else e5(acc, u, wr, wc, fr, fq); }
};

struct Epi6 {
    float* Y; float* part;
    __device__ __forceinline__ void init_acc(AccRef acc, const pg8::Unit& u, int wr, int wc, int fr, int fq) const {
        if (u.sel == 0) acc_load(acc, Y, u.pm * 256 + wr * 64 + fr, u.pn * 256 + wc * 32 + 8 * fq); else acc_zero(acc); }
    __device__ __forceinline__ bool keep(const pg8::Unit&) const { return false; }
    __device__ __forceinline__ void operator()(AccRef acc, const pg8::Unit& u, int wr, int wc, int fr, int fq) const {
        const int rt = wr * 64 + fr, cw = wc * 32 + 8 * fq;
        float* pb = (u.sel == 0) ? Y + (size_t)u.pm * 256 * DM + u.pn * 256 : part + ((size_t)(u.kofs / u.nkt) * 32 + (u.sel - 1)) * 65536;
        const int ld = (u.sel == 0) ? DM : 256;
#pragma unroll
        for (int ai = 0; ai < 2; ++ai)
#pragma unroll
            for (int m = 0; m < 4; ++m) { EPI_PIN(ai, m); float* rowp = pb + (size_t)(rt + ai * 128 + m * 16) * ld + cw;
#pragma unroll
                for (int bj = 0; bj < 2; ++bj) { *(f32x4*)(rowp + bj * 128) = aq[bj][0]; *(f32x4*)(rowp + bj * 128 + 4) = aq[bj][1]; } }
    }
};

__device__ __forceinline__ void p0_transpose_item(const float* W, int K, int N, bf16_t* WT, int drow0, int k0, int n0, LAS float* scr, int lane) {
    const int kq = lane >> 4, n4 = (lane & 15) * 4;
    f32x4 v[16];
#pragma unroll
    for (int i = 0; i < 16; ++i) v[i] = __builtin_nontemporal_load((const f32x4*)(W + (size_t)(k0 + 4 * i + kq) * N + n0 + n4));
#pragma unroll
    for (int i = 0; i < 16; ++i) { LAS float* p = scr + (4 * i + kq) * 65 + n4; p[0] = v[i][0]; p[1] = v[i][1]; p[2] = v[i][2]; p[3] = v[i][3]; }
    asm volatile("s_waitcnt lgkmcnt(0)" ::: "memory");
    const int c = lane & 7;
#pragma unroll
    for (int j = 0; j < 8; ++j) { const int n = (lane >> 3) + 8 * j; const LAS float* s = scr + (8 * c) * 65 + n;
        u32x4 o; o.x = cvt_pk_bf16(s[0 * 65], s[1 * 65]); o.y = cvt_pk_bf16(s[2 * 65], s[3 * 65]); o.z = cvt_pk_bf16(s[4 * 65], s[5 * 65]); o.w = cvt_pk_bf16(s[6 * 65], s[7 * 65]);
        *(u32x4*)(WT + (size_t)(drow0 + n) * K + k0 + 8 * c) = o; }
    asm volatile("s_waitcnt lgkmcnt(0)" ::: "memory");
}

constexpr int KS_STRIDE = 144;
constexpr int VT_STRIDE = 528;
constexpr int ATT_VT_OFF = 256 * KS_STRIDE;

template <int NKT>
__device__ __forceinline__ void attn_tile(LAS const unsigned char* Ks, LAS const unsigned char* VT, bf16x8 q0, bf16x8 q1, int qi, int kt0, bool mask_prev, float sink2, bf16_t* optr, int lane) {
    const int l15 = lane & 15, quad = lane >> 4;
    bf16x8 qf[2]; qf[0] = q0; qf[1] = q1;
    LAS const unsigned char* Kw = Ks + kt0 * 16 * KS_STRIDE; LAS const unsigned char* Vw = VT + kt0 * 32;
    f32x4 s[NKT];
#pragma unroll
    for (int nt = 0; nt < NKT; ++nt) { s[nt] = (f32x4){0.f, 0.f, 0.f, 0.f}; if ((nt & 1) == 0) asm volatile("" ::: "memory");
#pragma unroll
        for (int ks = 0; ks < 2; ++ks) { const bf16x8 a = *(LAS const bf16x8*)(Kw + (nt * 16 + l15) * KS_STRIDE + ks * 64 + quad * 16);
            s[nt] = __builtin_amdgcn_mfma_f32_16x16x32_bf16(a, qf[ks], s[nt], 0, 0, 0); } }
    float mx = NEGBIG;
#pragma unroll
    for (int nt = 0; nt < NKT; ++nt) {
        if (mask_prev || nt < 2 || nt >= 8) {
#pragma unroll
            for (int j = 0; j < 4; ++j) { const int kidx = (kt0 + nt) * 16 + quad * 4 + j, diff = 128 + qi - kidx;
                const bool valid = (diff >= 0) && (diff <= 128) && !(mask_prev && kidx < 128);
                s[nt][j] = valid ? s[nt][j] : NEGBIG; } }
#pragma unroll
        for (int j = 0; j < 4; ++j) mx = fmaxf(mx, s[nt][j]); }
    mx = fmaxf(mx, __shfl_xor(mx, 16)); mx = fmaxf(mx, __shfl_xor(mx, 32)); mx = fmaxf(mx, sink2);
    float sum = 0.f;
#pragma unroll
    for (int nt = 0; nt < NKT; ++nt)
#pragma unroll
        for (int j = 0; j < 4; ++j) { const float p = fast_exp2(s[nt][j] - mx); s[nt][j] = p; sum += p; }
    sum += __shfl_xor(sum, 16); sum += __shfl_xor(sum, 32);
    const float inv = 1.0f / (sum + fast_exp2(sink2 - mx));
    f32x4 o[4];
#pragma unroll
    for (int mt = 0; mt < 4; ++mt) o[mt] = (f32x4){0.f, 0.f, 0.f, 0.f};
#pragma unroll
    for (int i = 0; i < NKT / 2; ++i) {
        asm volatile("" ::: "memory");
        u32x4 pw; pw.x = cvt_pk_bf16(s[2 * i][0], s[2 * i][1]); pw.y = cvt_pk_bf16(s[2 * i][2], s[2 * i][3]); pw.z = cvt_pk_bf16(s[2 * i + 1][0], s[2 * i + 1][1]); pw.w = cvt_pk_bf16(s[2 * i + 1][2], s[2 * i + 1][3]);
        const bf16x8 pb = __builtin_bit_cast(bf16x8, pw);
#pragma unroll
        for (int mt = 0; mt < 4; ++mt) { LAS const unsigned char* vp = Vw + (mt * 16 + l15) * VT_STRIDE + (32 * i + quad * 4) * 2;
            const s16x4 lo = *(LAS const s16x4*)vp, hi = *(LAS const s16x4*)(vp + 32);
            const bf16x8 a = (bf16x8){lo[0], lo[1], lo[2], lo[3], hi[0], hi[1], hi[2], hi[3]};
            o[mt] = __builtin_amdgcn_mfma_f32_16x16x32_bf16(a, pb, o[mt], 0, 0, 0); }
    }
#pragma unroll
    for (int mt = 0; mt < 4; ++mt) { const f32x4 v = o[mt] * inv; u32x2 w; w.x = cvt_pk_bf16(v[0], v[1]); w.y = cvt_pk_bf16(v[2], v[3]);
        *(u32x2*)(optr + mt * 16 + quad * 4) = w; }
}

#define XB_TMO      128
#define XB_XCNT(j)  (256  + 64 * (j))
#define XB_XSUB(j)  (1280 + 64 * (j))
#define XB_XGEN(j)  (2304 + 64 * (j))
#define XB_TOP      3328
#define XB_TOPGEN   3392
#define XCD_BAR_WORDS 3456
#define XB_SPIN_CAP (1u << 18)
__device__ __forceinline__ unsigned xb_ld(unsigned* p)              { return __hip_atomic_load(p, __ATOMIC_RELAXED, __HIP_MEMORY_SCOPE_AGENT); }
__device__ __forceinline__ unsigned xb_add(unsigned* p, unsigned v) { return __hip_atomic_fetch_add(p, v, __ATOMIC_RELAXED, __HIP_MEMORY_SCOPE_AGENT); }
__device__ __forceinline__ unsigned xb_xcc_id() { return (unsigned)__builtin_amdgcn_s_getreg((3 << 11) | 20) & 0xFu; }
#define XB_SPIN(cond, bar) do { unsigned _sp = 0; while (cond) { __builtin_amdgcn_s_sleep(1); \
    if ((++_sp & 255u) == 0u) { if (xb_ld(&(bar)[XB_TMO])) break; if (_sp > XB_SPIN_CAP) { atomicAdd(&(bar)[XB_TMO], 1u); break; } } } } while (0)
struct XcdBarrier { unsigned* bar; unsigned x; volatile LAS unsigned* st; };
__device__ __forceinline__ XcdBarrier xcd_barrier_post(unsigned* bar, volatile LAS unsigned* st) {
    XcdBarrier b; b.bar = bar; b.x = xb_xcc_id(); b.st = st;
    if (threadIdx.x == 0) (void)xb_add(&bar[XB_XCNT(b.x)], 1u);
    return b;
}
__device__ __forceinline__ void xcd_barrier_complete(unsigned* bar, unsigned x, unsigned& nloc, unsigned& nx) {
    const unsigned G = gridDim.x * gridDim.y * gridDim.z;
    unsigned sum, cnt, mine, sp = 0u;
    for (;;) {
        sum = 0u; cnt = 0u; mine = 0u;
#pragma unroll
        for (unsigned j = 0; j < 16; ++j) { const unsigned c = xb_ld(&bar[XB_XCNT(j)]); sum += c; cnt += (c > 0u) ? 1u : 0u; mine = (j == x) ? c : mine; }
        if (sum == G) break;
        __builtin_amdgcn_s_sleep(1);
        if ((++sp & 255u) == 0u) { if (xb_ld(&bar[XB_TMO])) break; if (sp > XB_SPIN_CAP) { atomicAdd(&bar[XB_TMO], 1u); break; } }
    }
    nloc = mine > 0u ? mine : 1u; nx = cnt > 0u ? cnt : 1u;
}
__device__ __forceinline__ void xcd_barrier(const XcdBarrier& b) {
    asm volatile("s_waitcnt vmcnt(0)" ::: "memory");
    __syncthreads();
    if (threadIdx.x == 0) {
        unsigned* bar = b.bar;
        __builtin_amdgcn_s_waitcnt(0);
        unsigned nloc = b.st[0], nx = b.st[1];
        if (nloc == 0u) { xcd_barrier_complete(bar, b.x, nloc, nx); b.st[0] = nloc; b.st[1] = nx; }
        const unsigned old = xb_add(&bar[XB_XSUB(b.x)], 1u);
        const unsigned gen = old / nloc;
        if (old + 1u == (gen + 1u) * nloc) {
            __builtin_amdgcn_fence(__ATOMIC_RELEASE, "agent");
            asm volatile("s_waitcnt vmcnt(0)" ::: "memory");
            const unsigned og = xb_add(&bar[XB_TOP], 1u);
            const unsigned tg = og / nx;
            if (og + 1u == (tg + 1u) * nx) xb_add(&bar[XB_TOPGEN], 1u);
            else XB_SPIN(xb_ld(&bar[XB_TOPGEN]) == tg, bar);
            __builtin_amdgcn_fence(__ATOMIC_ACQUIRE, "agent");
            xb_add(&bar[XB_XGEN(b.x)], 1u);
            asm volatile("s_waitcnt vmcnt(0)" ::: "memory");
        } else {
            XB_SPIN(xb_ld(&bar[XB_XGEN(b.x)]) == gen, bar);
            __builtin_amdgcn_fence(__ATOMIC_ACQUIRE, "agent");
            asm volatile("s_waitcnt vmcnt(0)" ::: "memory");
        }
    }
    __syncthreads();
}

struct Args { const float* in[18]; float* out; unsigned char* ws; int ph_lo, ph_hi; };

__global__ void __launch_bounds__(NWAVES * 64, 2) fwd_megakernel(Args args) {
    extern __shared__ __attribute__((aligned(16))) unsigned char lds_raw[];
    LAS unsigned char* lds = (LAS unsigned char*)lds_raw;
    cg::grid_group grid = cg::this_grid();
    const int tid = threadIdx.x, lane = tid & 63, wave = __builtin_amdgcn_readfirstlane(tid >> 6);
    const int G = gridDim.x, bx = blockIdx.x;
    unsigned char* ws = args.ws; float* out = args.out;
    const float *x_prompt = args.in[0], *x_sample = args.in[1], *cache_k = args.in[2], *cache_v = args.in[3], *norm1_g = args.in[4], *w_in = args.in[5], *gmlp_g = args.in[6],
                *w_s = args.in[7], *b_s = args.in[8], *sinks = args.in[9], *w_pa = args.in[10], *w_pb = args.in[11], *w_o = args.in[12], *norm2_g = args.in[13],
                *w_ffg = args.in[14], *w_ffu = args.in[15], *w_ffd = args.in[16], *final_g = args.in[17];
    bf16_t *WinT = (bf16_t*)(ws + WS_WIN), *WpaT = (bf16_t*)(ws + WS_WPA), *WpbT = (bf16_t*)(ws + WS_WPB), *WoT = (bf16_t*)(ws + WS_WO), *WguT = (bf16_t*)(ws + WS_WGU), *WdT = (bf16_t*)(ws + WS_WD);
    float *STG = (float*)(ws + WS_STG), *SS2 = (float*)(ws + WS_SS2), *SS3 = (float*)(ws + WS_SS3);
    bf16_t *Hb = (bf16_t*)(ws + WS_H), *ATT = (bf16_t*)(ws + WS_ATT), *GM = (bf16_t*)(ws + WS_GM), *XG = (bf16_t*)(ws + WS_XG);
    bf16_t *Qb = (bf16_t*)(ws + WS_Q), *Kb = (bf16_t*)(ws + WS_K), *Vb = (bf16_t*)(ws + WS_V), *Ub = (bf16_t*)(ws + WS_U), *GVb = (bf16_t*)(ws + WS_GV), *MIX = (bf16_t*)(ws + WS_MIX);
    bf16_t* MIXS = (bf16_t*)(ws + WS_WIN) - (size_t)NPROMPT * DM;
    bf16_t *SAb = (bf16_t*)(out + O_Y), *SBb = SAb + (size_t)MROWS * DM, *ACT = (bf16_t*)(ws + WS_ACT);

    const int lo = args.ph_lo, hi = args.ph_hi;
#ifndef PHASE_MASK
#define PHASE_MASK 255
#endif
#define IN(k) (((PHASE_MASK >> (k)) & 1) && lo <= (k) && (k) < hi)
#define SEAM(k) do { if (IN(k) && IN((k) + 1)) xcd_barrier(xbar); } while (0)
    volatile LAS unsigned* xb_st = (volatile LAS unsigned*)(lds + XB_LDS_OFF);
    if (tid < 2) xb_st[tid] = 0u;
    __syncthreads();
    const XcdBarrier xbar = xcd_barrier_post((unsigned*)ws, xb_st);
    if (hi > 1000) grid.sync();
    const int gw = bx * NWAVES + wave, NGW = G * NWAVES;

    if (IN(0)) {
        LAS float* scr = (LAS float*)(lds + wave * 16640);
        constexpr int I_IN = 32 * 120;
        for (int it = gw; it < I_IN; it += NGW) { const int kb = it / 120, nb = it % 120; p0_transpose_item(w_in, DM, INW, WinT, 64 * nb, 64 * kb, 64 * nb, scr, lane); }
        for (int m = gw; m < MROWS; m += NGW) {
            const float* xr = (m < NPROMPT) ? x_prompt + (size_t)m * DM : x_sample + (size_t)(m - NPROMPT) * DM;
            f32x4 v[8]; float ss = 0.f;
#pragma unroll
            for (int j = 0; j < 8; ++j) { v[j] = *(const f32x4*)(xr + (j * 64 + lane) * 4); ss += (v[j][0] * v[j][0] + v[j][1] * v[j][1]) + (v[j][2] * v[j][2] + v[j][3] * v[j][3]); }
            const float rstd = __builtin_amdgcn_rsqf(wave_sum(ss) * (1.0f / DM) + EPS);
#pragma unroll
            for (int j = 0; j < 8; ++j) { const f32x4 gg = *(const f32x4*)(norm1_g + (j * 64 + lane) * 4); const f32x4 h = v[j] * rstd * gg;
                u32x2 w; w.x = cvt_pk_bf16(h[0], h[1]); w.y = cvt_pk_bf16(h[2], h[3]); *(u32x2*)(Hb + (size_t)m * DM + (j * 64 + lane) * 4) = w; }
        }
    }
    SEAM(0);

    const bool p1_split = (G == 256);
    const int p1_full = p1_split ? 4 : (1 << 20), p1_tail = p1_split ? 56 : 0;
    if (IN(1)) {
        pg8::Gemm g{Hb, WinT, Hb, WinT, MROWS, INW, DM}; pg8::P1Order S; S.a.init(MROWS, 14 * 256, DM, G, bx); S.b.init(MROWS, 16 * 256, DM, G, bx); S.lo = 0; S.hi = p1_full;
        Epi1 E{Qb, Kb, Vb, Ub, GVb, SAb, SBb, STG, out};
        pg8::gemm_phase<Epi1, pg8::P1Order>(lds, g, S, E);
    }
    SEAM(1);

    if (IN(2)) {
        int nitems, rank = bx - p1_tail; const bool tailwg = p1_split && bx < p1_tail;
        if (!p1_split) nitems = (1408 - bx + G - 1) / G;
        else if (tailwg) { nitems = (1408 - 1224 - bx + p1_tail - 1) / p1_tail;
            pg8::Gemm g{Hb, WinT, Hb, WinT, MROWS, INW, DM}; pg8::P1Order S; S.a.init(MROWS, 14 * 256, DM, G, bx); S.b.init(MROWS, 16 * 256, DM, G, bx); S.lo = p1_full; S.hi = p1_full + 1;
            Epi1 E{Qb, Kb, Vb, Ub, GVb, SAb, SBb, STG, out};
            pg8::gemm_phase<Epi1, pg8::P1Order>(lds, g, S, E); }
        else nitems = (rank < 56) ? 4 : 8;
        int ws_g = -1;
        for (int k = 0; k < nitems; ++k) {
            int it;
            if (!p1_split) it = bx + k * G;
            else if (tailwg) it = 1224 + bx + k * p1_tail;
            else if (rank < 56) it = (k < 2) ? rank + 200 * k : 256 + rank + 56 * (k - 2);
            else { const int r2 = rank - 56;
                if (k == 0) it = rank;
                else if (k < 4) { it = 256 + 112 + r2 + 144 * (k - 1); if (it >= 768) it = -1; }
                else { it = 768 + r2 + 144 * (k - 4); if (it >= 1224) it = -1; } }
            if (it < 0) continue;
            if (it < 256) {
                const int b = it >> 6, n = (it >> 2) & 15, h = it & 3; ws_g = -1;
                LAS unsigned char* Ks = lds; LAS unsigned char* VT = lds + ATT_VT_OFF;
                const int r = wave >> 1, head = h * 4 + r; const float sink2 = sinks[head] * LOG2E;
                const bf16_t* qbase = Qb + (size_t)(b * SEQ + n * 128 + (wave & 1) * 64 + (lane & 15)) * QW + head * 64 + (lane >> 4) * 8;
                bf16x8 qc0 = *(const bf16x8*)qbase, qc1 = *(const bf16x8*)(qbase + 32);
#pragma unroll
                for (int p = 0; p < 4; ++p) { const int key = p * 64 + (tid >> 3), chunk = tid & 7, pos = (n - 1) * 128 + key;
                    u32x4 v = (u32x4){0u, 0u, 0u, 0u}; if (pos >= 0) v = *(const u32x4*)(Kb + (size_t)(b * SEQ + pos) * KVW + h * 64 + chunk * 8);
                    *(LAS u32x4*)(Ks + key * KS_STRIDE + chunk * 16) = v; }
#pragma unroll
                for (int p = 0; p < 4; ++p) { const int idx = p * 512 + tid, key = idx & 255, chunk = idx >> 8, pos = (n - 1) * 128 + key;
                    u32x4 v = (u32x4){0u, 0u, 0u, 0u}; if (pos >= 0) v = *(const u32x4*)(Vb + (size_t)(b * SEQ + pos) * KVW + h * 64 + chunk * 8);
                    LAS unsigned short* vt = (LAS unsigned short*)(VT + (chunk * 8) * VT_STRIDE + key * 2);
                    vt[0 * (VT_STRIDE / 2)] = (unsigned short)(v.x & 0xffff); vt[1 * (VT_STRIDE / 2)] = (unsigned short)(v.x >> 16);
                    vt[2 * (VT_STRIDE / 2)] = (unsigned short)(v.y & 0xffff); vt[3 * (VT_STRIDE / 2)] = (unsigned short)(v.y >> 16);
                    vt[4 * (VT_STRIDE / 2)] = (unsigned short)(v.z & 0xffff); vt[5 * (VT_STRIDE / 2)] = (unsigned short)(v.z >> 16);
                    vt[6 * (VT_STRIDE / 2)] = (unsigned short)(v.w & 0xffff); vt[7 * (VT_STRIDE / 2)] = (unsigned short)(v.w >> 16); }
                __syncthreads();
#pragma unroll 1
                for (int mt = 0; mt < 4; ++mt) { const int qt = (wave & 1) * 4 + mt, qi = qt * 16 + (lane & 15); const size_t qoff = (size_t)(b * SEQ + n * 128 + qi) * QW + head * 64;
                    const bf16_t* qn = qbase + (size_t)(mt < 3 ? mt + 1 : 3) * 16 * QW; const bf16x8 qn0 = *(const bf16x8*)qn, qn1 = *(const bf16x8*)(qn + 32);
                    attn_tile<10>(Ks, VT, qc0, qc1, qi, qt < 6 ? qt : 6, n == 0, sink2, ATT + qoff, lane);
                    qc0 = qn0; qc1 = qn1; }
                asm volatile("s_waitcnt lgkmcnt(0)\n\ts_barrier" ::: "memory");
            } else if (it < 768) {
                const int id = it - 256, g = id & 7, c = (id >> 3) & 15, b = id >> 7; const int R0 = b * SEQ + c * 128;
                LAS unsigned char* wsL = lds; LAS unsigned char* vnT = lds + 34816; LAS float* stat = (LAS float*)(lds + 69632);
                u32x4 gvv[4];
#pragma unroll
                for (int p = 0; p < 4; ++p) { const int idx = p * 512 + tid, s_ = idx & 127, dc = idx >> 7; gvv[p] = *(const u32x4*)(GVb + (size_t)(R0 + s_) * GW + g * 128 + dc * 8); }
                if (tid < 128) { const float* sp = STG + (size_t)(R0 + tid) * 32; float s = 0.f, q = 0.f;
#pragma unroll
                    for (int j = 0; j < 8; ++j) { const f32x4 v = *(const f32x4*)(sp + 4 * j); s += v[0] + v[2]; q += v[1] + v[3]; }
                    const float mean = s * (1.0f / GW), var = fmaxf(q * (1.0f / GW) - mean * mean, 0.f);
                    stat[2 * tid] = mean; stat[2 * tid + 1] = __builtin_amdgcn_rsqf(var + EPS); }
                if (ws_g != g) { ws_g = g;
#pragma unroll
                for (int p = 0; p < 8; ++p) { const int idx = p * 512 + tid, t = idx >> 5, s4 = (idx & 31) * 4; const f32x4 w = *(const f32x4*)(w_s + ((size_t)g * 128 + t) * 128 + s4);
                    u32x2 o; o.x = cvt_pk_bf16(s4 + 0 <= t ? w[0] : 0.f, s4 + 1 <= t ? w[1] : 0.f); o.y = cvt_pk_bf16(s4 + 2 <= t ? w[2] : 0.f, s4 + 3 <= t ? w[3] : 0.f);
                    *(LAS u32x2*)(wsL + t * 272 + s4 * 2) = o; } }
                __syncthreads();
#pragma unroll
                for (int p = 0; p < 4; ++p) { const int idx = p * 512 + tid, s = idx & 127, dc = idx >> 7; const u32x4 v = gvv[p];
                    const float mean = stat[2 * s], rstd = stat[2 * s + 1]; const f32x4 ga = *(const f32x4*)(gmlp_g + g * 128 + dc * 8), gb = *(const f32x4*)(gmlp_g + g * 128 + dc * 8 + 4);
                    LAS unsigned short* vt = (LAS unsigned short*)(vnT + (dc * 8) * 272 + s * 2);
                    const unsigned w0 = cvt_pk_bf16((bf_lo(v.x) - mean) * rstd * ga[0], (bf_hi(v.x) - mean) * rstd * ga[1]), w1 = cvt_pk_bf16((bf_lo(v.y) - mean) * rstd * ga[2], (bf_hi(v.y) - mean) * rstd * ga[3]);
                    const unsigned w2 = cvt_pk_bf16((bf_lo(v.z) - mean) * rstd * gb[0], (bf_hi(v.z) - mean) * rstd * gb[1]), w3 = cvt_pk_bf16((bf_lo(v.w) - mean) * rstd * gb[2], (bf_hi(v.w) - mean) * rstd * gb[3]);
                    vt[0 * 136] = (unsigned short)(w0 & 0xffff); vt[1 * 136] = (unsigned short)(w0 >> 16); vt[2 * 136] = (unsigned short)(w1 & 0xffff); vt[3 * 136] = (unsigned short)(w1 >> 16);
                    vt[4 * 136] = (unsigned short)(w2 & 0xffff); vt[5 * 136] = (unsigned short)(w2 >> 16); vt[6 * 136] = (unsigned short)(w3 & 0xffff); vt[7 * 136] = (unsigned short)(w3 >> 16); }
                __syncthreads();
                {
                    const int l15 = lane & 15, quad = lane >> 4;
                    f32x4 acc[8];
#pragma unroll
                    for (int dt = 0; dt < 8; ++dt) acc[dt] = (f32x4){0.f, 0.f, 0.f, 0.f};
                    const int ksmax = wave >> 1;
                    const int t = wave * 16 + l15; const float bias = b_s[g * 128 + t]; const size_t off = (size_t)(R0 + t) * GW + g * 128 + quad * 4;
                    u32x2 uw[8];
#pragma unroll
                    for (int dt = 0; dt < 8; ++dt) uw[dt] = *(const u32x2*)(Ub + off + dt * 16);
#pragma unroll 1
                    for (int ks = 0; ks <= ksmax; ++ks) { const bf16x8 a = *(LAS const bf16x8*)(wsL + (wave * 16 + l15) * 272 + ks * 64 + quad * 16);
#pragma unroll
                        for (int dt = 0; dt < 8; ++dt) { const bf16x8 bb = *(LAS const bf16x8*)(vnT + (dt * 16 + l15) * 272 + ks * 64 + quad * 16);
                            acc[dt] = __builtin_amdgcn_mfma_f32_16x16x32_bf16(bb, a, acc[dt], 0, 0, 0); } }
#pragma unroll
                    for (int dt = 0; dt < 8; ++dt) { u32x2 w; w.x = cvt_pk_bf16(bf_lo(uw[dt].x) * (acc[dt][0] + bias), bf_hi(uw[dt].x) * (acc[dt][1] + bias));
                        w.y = cvt_pk_bf16(bf_lo(uw[dt].y) * (acc[dt][2] + bias), bf_hi(uw[dt].y) * (acc[dt][3] + bias)); *(u32x2*)(GM + off + dt * 16) = w; }
                }
                asm volatile("s_waitcnt lgkmcnt(0)\n\ts_barrier" ::: "memory");
            } else if (it < 1280) {
                const int id = it - 768, b = id >> 2, h = id & 3; ws_g = -1;
                LAS unsigned char* Ks = lds; LAS unsigned char* VT = lds + ATT_VT_OFF;
                const int sl15 = lane & 15, st = sl15 & 7, shead = h * 4 + 2 * (wave & 1) + (sl15 >> 3); const size_t sqoff = (size_t)(NPROMPT + b * 8 + st) * QW + shead * 64;
                const bf16x8 sq0 = *(const bf16x8*)(Qb + sqoff + (lane >> 4) * 8), sq1 = *(const bf16x8*)(Qb + sqoff + 32 + (lane >> 4) * 8);
                { const int key = tid >> 2, part = tid & 3; const float* src = cache_k + ((size_t)(b * 128 + key) * 4 + h) * 64 + part * 16;
                    const f32x4 a0 = *(const f32x4*)src, a1 = *(const f32x4*)(src + 4), a2 = *(const f32x4*)(src + 8), a3 = *(const f32x4*)(src + 12);
                    u32x4 w0, w1; w0.x = cvt_pk_bf16(a0[0], a0[1]); w0.y = cvt_pk_bf16(a0[2], a0[3]); w0.z = cvt_pk_bf16(a1[0], a1[1]); w0.w = cvt_pk_bf16(a1[2], a1[3]);
                    w1.x = cvt_pk_bf16(a2[0], a2[1]); w1.y = cvt_pk_bf16(a2[2], a2[3]); w1.z = cvt_pk_bf16(a3[0], a3[1]); w1.w = cvt_pk_bf16(a3[2], a3[3]);
                    *(LAS u32x4*)(Ks + key * KS_STRIDE + part * 32) = w0; *(LAS u32x4*)(Ks + key * KS_STRIDE + part * 32 + 16) = w1; }
                if (tid < 64) { const int key = 128 + (tid >> 3), chunk = tid & 7; *(LAS u32x4*)(Ks + key * KS_STRIDE + chunk * 16) = *(const u32x4*)(Kb + (size_t)(NPROMPT + b * 8 + (tid >> 3)) * KVW + h * 64 + chunk * 8); }
                else if (tid < 256) { const int key = 136 + ((tid - 64) >> 3), chunk = (tid - 64) & 7; *(LAS u32x4*)(Ks + key * KS_STRIDE + chunk * 16) = (u32x4){0u, 0u, 0u, 0u}; }
                { const int key = tid & 127, part = tid >> 7; const float* src = cache_v + ((size_t)(b * 128 + key) * 4 + h) * 64 + part * 16;
                    LAS unsigned short* vt = (LAS unsigned short*)(VT + (part * 16) * VT_STRIDE + key * 2);
#pragma unroll
                    for (int q4 = 0; q4 < 4; ++q4) { const f32x4 a = *(const f32x4*)(src + 4 * q4); const unsigned w0 = cvt_pk_bf16(a[0], a[1]), w1 = cvt_pk_bf16(a[2], a[3]);
                        vt[(4 * q4 + 0) * (VT_STRIDE / 2)] = (unsigned short)(w0 & 0xffff); vt[(4 * q4 + 1) * (VT_STRIDE / 2)] = (unsigned short)(w0 >> 16);
                        vt[(4 * q4 + 2) * (VT_STRIDE / 2)] = (unsigned short)(w1 & 0xffff); vt[(4 * q4 + 3) * (VT_STRIDE / 2)] = (unsigned short)(w1 >> 16); } }
                if (tid < 64) { const int key = 128 + (tid & 7), chunk = tid >> 3; const u32x4 v = *(const u32x4*)(Vb + (size_t)(NPROMPT + b * 8 + (tid & 7)) * KVW + h * 64 + chunk * 8);
                    LAS unsigned short* vt = (LAS unsigned short*)(VT + (chunk * 8) * VT_STRIDE + key * 2);
                    vt[0 * (VT_STRIDE / 2)] = (unsigned short)(v.x & 0xffff); vt[1 * (VT_STRIDE / 2)] = (unsigned short)(v.x >> 16);
                    vt[2 * (VT_STRIDE / 2)] = (unsigned short)(v.y & 0xffff); vt[3 * (VT_STRIDE / 2)] = (unsigned short)(v.y >> 16);
                    vt[4 * (VT_STRIDE / 2)] = (unsigned short)(v.z & 0xffff); vt[5 * (VT_STRIDE / 2)] = (unsigned short)(v.z >> 16);
                    vt[6 * (VT_STRIDE / 2)] = (unsigned short)(v.w & 0xffff); vt[7 * (VT_STRIDE / 2)] = (unsigned short)(v.w >> 16); }
                for (int idx = tid; idx < 24 * 64; idx += 512) { const int d = idx / 24, key = 136 + idx % 24; *(LAS unsigned short*)(VT + d * VT_STRIDE + key * 2) = 0; }
                __syncthreads();
                if (wave < 2) attn_tile<10>(Ks, VT, sq0, sq1, st, 0, false, sinks[shead] * LOG2E, ATT + sqoff, lane);
                asm volatile("s_waitcnt lgkmcnt(0)\n\ts_barrier" ::: "memory");
            } else {
                const int b = it - 1280, R0 = NPROMPT + b * 8; ws_g = -1;
                LAS float* stat = (LAS float*)lds;
                const int c = 2 * tid, g = wave;
                unsigned gvw[8], uw[8];
#pragma unroll
                for (int s_ = 0; s_ < 8; ++s_) { gvw[s_] = *(const unsigned*)(GVb + (size_t)(R0 + s_) * GW + c); uw[s_] = *(const unsigned*)(Ub + (size_t)(R0 + s_) * GW + c); }
                const f32x2 gam = *(const f32x2*)(gmlp_g + c);
                if (tid < 8) { const float* sp = STG + (size_t)(R0 + tid) * 32; float sm = 0.f, q = 0.f;
#pragma unroll
                    for (int j2 = 0; j2 < 8; ++j2) { const f32x4 v = *(const f32x4*)(sp + 4 * j2); sm += v[0] + v[2]; q += v[1] + v[3]; }
                    const float mean = sm * (1.0f / GW), var = fmaxf(q * (1.0f / GW) - mean * mean, 0.f);
                    stat[2 * tid] = mean; stat[2 * tid + 1] = __builtin_amdgcn_rsqf(var + EPS); }
                __syncthreads();
                float vn0[8], vn1[8];
#pragma unroll
                for (int s_ = 0; s_ < 8; ++s_) { const float mean = stat[2 * s_], rstd = stat[2 * s_ + 1];
                    vn0[s_] = (bf_lo(gvw[s_]) - mean) * rstd * gam[0]; vn1[s_] = (bf_hi(gvw[s_]) - mean) * rstd * gam[1];
                    *(f32x2*)(out + O_SG + (size_t)(b * 8 + s_) * GW + c) = (f32x2){vn0[s_], vn1[s_]}; }
#pragma unroll
                for (int t = 0; t < 8; ++t) { float m0 = b_s[g * 128 + t], m1 = m0;
#pragma unroll
                    for (int s_ = 0; s_ < 8; ++s_) if (s_ <= t) { const float w = w_s[((size_t)g * 128 + t) * 128 + s_]; m0 += w * vn0[s_]; m1 += w * vn1[s_]; }
                    *(unsigned*)(GM + (size_t)(R0 + t) * GW + c) = cvt_pk_bf16(bf_lo(uw[t]) * m0, bf_hi(uw[t]) * m1); }
                asm volatile("s_waitcnt lgkmcnt(0)\n\ts_barrier" ::: "memory");
            }
        }
        {
            const int rank = p1_split ? bx : bx, cnt = p1_split ? p1_tail : G;
            if (!p1_split || bx < p1_tail) { LAS float* scr = (LAS float*)(lds + wave * 16640);
                for (int it = rank * NWAVES + wave; it < 2 * 16 * 32; it += cnt * NWAVES) { const int r = it & 511, kb = r / 32, nb = r % 32;
                    if (it < 512) p0_transpose_item(w_pa, GW, DM, WpaT, 64 * nb, 64 * kb, 64 * nb, scr, lane); else p0_transpose_item(w_pb, QW, DM, WpbT, 64 * nb, 64 * kb, 64 * nb, scr, lane); } }
        }
    }
    SEAM(2);

    if (IN(3)) {
        pg8::Gemm g{GM, WpaT, ATT, WpbT, MROWS, DM, GW}; pg8::DualOrder S; S.b.init(MROWS, DM, GW, G, bx);
        Epi3 E{SAb, SBb, MIX, MIXS};
        pg8::gemm_phase<Epi3, pg8::DualOrder, true>(lds, g, S, E);
        const int rem = S.b.nwg % G, cnt = rem ? G - rem : G, rank = rem ? bx - rem : bx;
        if (rank >= 0) {
            LAS float* scr = (LAS float*)(lds + wave * 16640);
            constexpr int I_O = 32 * 32, I_FF = 32 * 88, NIT = I_O + 2 * I_FF;
            for (int it = rank * NWAVES + wave; it < NIT; it += cnt * NWAVES) {
                int r = it;
                if (r < I_O) { const int kb = r / 32, nb = r % 32; p0_transpose_item(w_o, DM, DM, WoT, 64 * nb, 64 * kb, 64 * nb, scr, lane); continue; } r -= I_O;
                if (r < I_FF) { const int kb = r / 88, nb = r % 88, n0 = 64 * nb; p0_transpose_item(w_ffg, DM, DFF, WguT, 256 * (n0 >> 7) + (n0 & 127), 64 * kb, n0, scr, lane); continue; } r -= I_FF;
                { const int kb = r / 88, nb = r % 88, n0 = 64 * nb; p0_transpose_item(w_ffu, DM, DFF, WguT, 256 * (n0 >> 7) + 128 + (n0 & 127), 64 * kb, n0, scr, lane); }
            }
        }
    }
    SEAM(3);

    if (IN(4)) {
        const bool split45 = (G == 256);
#pragma unroll 1
        for (int sp = 0; sp < 3; ++sp) {
            pg8::Ph45Order S; S.p4p.init(NPROMPT, DM, DM, G, bx); S.p4s.init(NSAMPLE, DM, DM, G, bx); S.p5p.init(NPROMPT, 2 * DFF, DM, G, bx); S.p5s.init(NSAMPLE, 2 * DFF, DM, G, bx);
            S.p4all.init(MROWS, DM, DM, G, bx); S.p5all.init(MROWS, 2 * DFF, DM, G, bx); S.sp = sp; S.split = split45;
            pg8::Gemm g{XG, WguT, (sp == 1 && split45) ? MIXS : MIX, WoT, MROWS, 0, DM};
            Epi45 E{Epi4{x_prompt, x_sample, norm2_g, out + O_Y, XG, SS2}, Epi5{SS2, ACT}};
            pg8::gemm_phase<Epi45, pg8::Ph45Order, true>(lds, g, S, E);
            if (sp == 2) {
                const int rank = split45 ? bx - 112 : bx, cnt = split45 ? 144 : G;
                if (rank >= 0) { LAS float* scr = (LAS float*)(lds + wave * 16640);
                    for (int it = rank * NWAVES + wave; it < 88 * 32; it += cnt * NWAVES) { const int kb = it / 32, nb = it % 32; p0_transpose_item(w_ffd, DFF, DM, WdT, 64 * nb, 64 * kb, 64 * nb, scr, lane); }
                    const int NV = DECB * 120 * 64;
                    for (int i0 = rank * 2048 + tid; i0 < 2 * NV; i0 += cnt * 2048) { f32x4 t[4]; float* dp[4];
#pragma unroll
                        for (int q = 0; q < 4; ++q) { const int i = i0 + q * 512; const int which = i >= NV, r = which ? i - NV : i; const int sb = r / (120 * 64), rem2 = r % (120 * 64);
                            t[q] = __builtin_nontemporal_load((const f32x4*)((which ? cache_v : cache_k) + (size_t)sb * 128 * 256 + 8 * 256 + rem2 * 4));
                            dp[q] = out + (which ? O_SV : O_SK) + (size_t)sb * 128 * 256 + rem2 * 4; }
#pragma unroll
                        for (int q = 0; q < 4; ++q) *(f32x4*)dp[q] = t[q]; } }
            }
            if (sp < 2) xcd_barrier(xbar);
        }
    }
    SEAM(5);

    if (IN(6)) {
        const bool split6 = (G == 256);
        int lane6 = threadIdx.x; asm volatile("" : "+v"(lane6)); lane6 &= 63;
        const float* part = (const float*)(ws + WS_PART);
        {
            pg8::Gemm g{ACT, WdT, ACT, WdT, MROWS, DM, DFF}; pg8::SplitTailOrder S; S.p.init(NPROMPT, DM, DFF, G, bx); S.all.init(MROWS, DM, DFF, G, bx); S.pass = 0; S.split = split6;
            Epi6 E{out + O_Y, (float*)(ws + WS_PART)};
            pg8::gemm_phase<Epi6, pg8::SplitTailOrder>(lds, g, S, E);
        }
        xcd_barrier(xbar);
        if (split6 && bx < 128) {
            pg8::Gemm g{ACT, WdT, ACT, WdT, MROWS, DM, DFF}; pg8::SplitTailOrder S; S.p.init(NPROMPT, DM, DFF, G, bx); S.all.init(MROWS, DM, DFF, G, bx); S.pass = 1; S.split = true;
            Epi6 E{out + O_Y, (float*)(ws + WS_PART)};
            pg8::gemm_phase<Epi6, pg8::SplitTailOrder>(lds, g, S, E);
        } else if (split6) {
            for (int m = (bx - 128) * NWAVES + wave; m < NPROMPT; m += 128 * NWAVES) {
                float* yr = out + O_Y + (size_t)m * DM; f32x4 v[8]; float ss = 0.f;
#pragma unroll
                for (int j = 0; j < 8; ++j) { v[j] = *(const f32x4*)(yr + (j * 64 + lane6) * 4); ss += (v[j][0] * v[j][0] + v[j][1] * v[j][1]) + (v[j][2] * v[j][2] + v[j][3] * v[j][3]); }
                const float rstd = __builtin_amdgcn_rsqf(wave_sum(ss) * (1.0f / DM) + EPS);
#pragma unroll
                for (int j = 0; j < 8; ++j) { const f32x4 gg = *(const f32x4*)(final_g + (j * 64 + lane6) * 4); *(f32x4*)(yr + (j * 64 + lane6) * 4) = v[j] * rstd * gg; }
            }
        }
        xcd_barrier(xbar);
        for (int m = (split6 ? NPROMPT : 0) + gw; m < MROWS; m += NGW) {
            float* yr = out + O_Y + (size_t)m * DM; f32x4 v[8]; float ss = 0.f;
#pragma unroll
            for (int j = 0; j < 8; ++j) v[j] = *(const f32x4*)(yr + (j * 64 + lane6) * 4);
            if (split6) {
#pragma unroll
                for (int j = 0; j < 8; ++j) { const int tl = j * 4 + ((m >> 8) - 32); if ((j & 1) == 0) asm volatile("" ::: "memory");
#pragma unroll
                    for (int sp = 0; sp < 4; ++sp) v[j] += *(const f32x4*)(part + ((size_t)sp * 32 + tl) * 65536 + (size_t)(m & 255) * 256 + lane6 * 4); } }
#pragma unroll
            for (int j = 0; j < 8; ++j) ss += (v[j][0] * v[j][0] + v[j][1] * v[j][1]) + (v[j][2] * v[j][2] + v[j][3] * v[j][3]);
            const float rstd = __builtin_amdgcn_rsqf(wave_sum(ss) * (1.0f / DM) + EPS);
#pragma unroll
            for (int j = 0; j < 8; ++j) { const f32x4 gg = *(const f32x4*)(final_g + (j * 64 + lane6) * 4); *(f32x4*)(yr + (j * 64 + lane6) * 4) = v[j] * rstd * gg; }
        }
    }
#undef IN
#undef SEAM
}

extern "C" void kernel_launch(void* const* d_in, const int* in_sizes, int n_in, void* d_out, int out_size, void* d_ws, size_t ws_size, hipStream_t stream) {
    static int grid_blocks = 0;
    if (grid_blocks == 0) {
        if (n_in != 18 || ws_size < WS_END) { fprintf(stderr, "kernel_launch: expected 18 inputs and >= %zu bytes of workspace (got %d, %zu)\n", (size_t)WS_END, n_in, ws_size); grid_blocks = -1; return; }
        int dev = 0, cus = 0, per_cu = 0;
        hipGetDevice(&dev);
        hipDeviceGetAttribute(&cus, hipDeviceAttributeMultiprocessorCount, dev);
        if (hipFuncSetAttribute((const void*)fwd_megakernel, hipFuncAttributeMaxDynamicSharedMemorySize, LDS_BYTES) != hipSuccess) { fprintf(stderr, "kernel_launch: hipFuncSetAttribute failed\n"); grid_blocks = -1; return; }
        if (hipOccupancyMaxActiveBlocksPerMultiprocessor(&per_cu, (const void*)fwd_megakernel, NWAVES * 64, LDS_BYTES) != hipSuccess || per_cu < 1) { fprintf(stderr, "kernel_launch: occupancy query reports %d blocks per CU\n", per_cu); per_cu = 1; (void)hipGetLastError(); }
        grid_blocks = cus * (per_cu > 1 ? 1 : per_cu);
    }
    if (grid_blocks < 0) return;
    Args a{};
    for (int i = 0; i < 18; ++i) a.in[i] = (const float*)d_in[i];
    a.out = (float*)d_out; a.ws = (unsigned char*)d_ws;
    a.ph_lo = 0; a.ph_hi = 8;
    if (hipMemsetAsync(d_ws, 0, 16384, stream) != hipSuccess) { fprintf(stderr, "kernel_launch: hipMemsetAsync of the barrier words failed\n"); return; }
    void* kargs[] = {&a};
    hipError_t e = hipLaunchCooperativeKernel((const void*)fwd_megakernel, dim3(grid_blocks), dim3(NWAVES * 64), kargs, LDS_BYTES, stream);
    if (e != hipSuccess) fprintf(stderr, "kernel_launch: cooperative launch failed: %s (grid %d)\n", hipGetErrorString(e), grid_blocks);
}
```

```cpp
#include <hip/hip_runtime.h>
#include <hip/hip_cooperative_groups.h>
#include <cstdio>
#include <cstdint>
namespace cg = cooperative_groups;


#define LAS __attribute__((address_space(3)))
typedef unsigned short bf16_t;
typedef short bf16x8 __attribute__((ext_vector_type(8)));
typedef short s16x4 __attribute__((ext_vector_type(4)));
typedef float f32x4 __attribute__((ext_vector_type(4)));
typedef float f32x2 __attribute__((ext_vector_type(2)));
typedef unsigned u32x4 __attribute__((ext_vector_type(4)));
typedef unsigned u32x2 __attribute__((ext_vector_type(2)));

constexpr int DM = 2048, NPROMPT = 8192, NSAMPLE = 1024, MROWS = NPROMPT + NSAMPLE;
constexpr int SEQ = 2048, NBATCH = 4, DECB = 128, DECT = 8;
constexpr int QW = 1024, KVW = 256, GW = 1024, DFF = 5632, INW = 7680;
constexpr float EPS = 1e-6f;
constexpr float LOG2E = 1.4426950408889634f;
constexpr float QSCALE = 0.125f * LOG2E;
constexpr float NEGBIG = -1e30f;

constexpr size_t O_Y = 0;
constexpr size_t O_PK = (size_t)MROWS * DM;
constexpr size_t O_PV = O_PK + 4 * 128 * 256;
constexpr size_t O_SK = O_PV + 4 * 128 * 256;
constexpr size_t O_SV = O_SK + (size_t)DECB * 128 * 256;
constexpr size_t O_SG = O_SV + (size_t)DECB * 128 * 256;

constexpr size_t MiB = 1u << 20;
constexpr size_t WS_WIN = 1 * MiB, WS_WPA = 31 * MiB, WS_WPB = 35 * MiB, WS_WO = 39 * MiB, WS_WGU = 47 * MiB, WS_WD = 91 * MiB;
constexpr size_t WS_STG = 113 * MiB, WS_SS2 = 115 * MiB, WS_SS3 = 117 * MiB;
constexpr size_t WS_A = 119 * MiB;
constexpr size_t WS_PART = WS_A;
constexpr size_t WS_H = WS_A, WS_XG = WS_A;
constexpr size_t WS_ATT = 218 * MiB, WS_GM = 236 * MiB;
constexpr size_t WS_B = 155 * MiB;
constexpr size_t WS_Q = WS_B, WS_K = WS_B + 18 * MiB, WS_V = WS_K + 4608 * 1024, WS_U = WS_B + 27 * MiB, WS_GV = WS_B + 45 * MiB, WS_MIX = WS_B;
constexpr size_t WS_ACT = WS_B;
constexpr size_t WS_END = 254 * MiB;

constexpr int NWAVES = 8;
constexpr int LDS_BYTES = 147456;
constexpr int XB_LDS_OFF = 139264;

typedef __bf16 bf16x2_t __attribute__((ext_vector_type(2)));
__device__ __forceinline__ unsigned cvt_pk_bf16(float lo, float hi) { const f32x2 v = {lo, hi}; const bf16x2_t b = __builtin_convertvector(v, bf16x2_t); return __builtin_bit_cast(unsigned, b); }
__device__ __forceinline__ float bf_lo(unsigned w) { return __uint_as_float(w << 16); }
__device__ __forceinline__ float bf_hi(unsigned w) { return __uint_as_float(w & 0xffff0000u); }
__device__ __forceinline__ float bf1(bf16_t b) { return __uint_as_float((unsigned)b << 16); }
__device__ __forceinline__ float fast_rcp(float x) { return __builtin_amdgcn_rcpf(x); }
__device__ __forceinline__ float fast_exp2(float x) { return __builtin_amdgcn_exp2f(x); }
__device__ __forceinline__ float sigmoid_f(float x) { return fast_rcp(1.0f + fast_exp2(-LOG2E * x)); }
__device__ __forceinline__ float gelu_tanh_f(float x) { const float t = x + 0.044715f * x * x * x; return x * fast_rcp(1.0f + fast_exp2(-2.3022081983f * t)); }
__device__ __forceinline__ float wave_sum(float v) {
#pragma unroll
    for (int o = 1; o < 64; o <<= 1) v += __shfl_xor(v, o);
    return v;
}

namespace pg8 {
constexpr int BM = 256, BK = 64, HALF = 128, HTB = HALF * BK * 2, STAGE_BYTES = 8 * HTB, NXCD = 8, WGM = 8;
__host__ __device__ __forceinline__ int lds_byte(int r, int c) { const int st = (r >> 4) * 2 + (c >> 5), rr = r & 15, cc = c & 31, ob = rr * 64 + cc * 2; return st * 1024 + (ob ^ (((ob >> 9) & 1) << 5)); }
__host__ __device__ __forceinline__ void stage_rc(int b, int& R, int& C) { const int st = b / 1024, sb = b % 1024, swz = sb ^ (((sb >> 9) & 1) << 5); R = (st >> 1) * 16 + swz / 64; C = (st & 1) * 32 + (swz % 64) / 2; }
__host__ __device__ __forceinline__ int perm32(int rho) { const int n = rho >> 4, i = rho & 15; return 8 * (i >> 2) + 4 * n + (i & 3); }

struct Unit { int pm, pn, sel, kofs, nkt; };
struct Gemm { const bf16_t* A0; const bf16_t* B0; const bf16_t* A1; const bf16_t* B1; int M, N, K; };

struct StaticOrder {
    int nM, nN, nwg, G, c;
    __device__ void init(int M, int N, int K, int G_, int c_) { nM = M / BM; nN = N / BM; nwg = nM * nN; G = G_; c = c_; nkt = K / BK; }
    int nkt;
    __device__ void tile(int wgid, Unit& u) const {
        const int nig = WGM * nN, gid = wgid / nig, fm = gid * WGM, gsz = (nM - fm) < WGM ? (nM - fm) : WGM;
        u.pm = fm + ((wgid % nig) % gsz); u.pn = (wgid % nig) / gsz; u.sel = 0; u.kofs = 0; u.nkt = nkt;
    }
    __device__ bool next(int i, Unit& u) const {
        const long L = (long)i * G + c; if (L >= nwg) return false;
        int wgid = (int)L; { const int q = nwg / NXCD, r = nwg % NXCD, xcd = wgid % NXCD, off = wgid / NXCD; wgid = (xcd < r ? xcd * (q + 1) : r * (q + 1) + (xcd - r) * q) + off; }
        tile(wgid, u); return true;
    }
};
struct P1Order {
    StaticOrder a, b; int lo, hi;
    __device__ bool next(int i, Unit& u) const {
        const int r = lo + i; if (r >= hi) return false;
        long L = (long)r * a.G + a.c;
        const StaticOrder& s = (L < a.nwg) ? a : b; if (L >= a.nwg) L -= a.nwg;
        if (L >= s.nwg) return false;
        int wgid = (int)L; { const int q = s.nwg / NXCD, rr = s.nwg % NXCD, xcd = wgid % NXCD, off = wgid / NXCD; wgid = (xcd < rr ? xcd * (q + 1) : rr * (q + 1) + (xcd - rr) * q) + off; }
        s.tile(wgid, u); if (&s == &b) u.pn += 14; return true;
    }
};
struct DualOrder {
    StaticOrder b;
    __device__ bool next(int i, Unit& u) const { if (!b.next(i >> 1, u)) return false; u.sel = i & 1; return true; }
};

struct Ph45Order {
    StaticOrder p4p, p4s, p5p, p5s, p4all, p5all; int sp; bool split;
    __device__ static int swz(const StaticOrder& s, long L) { const int w = (int)L, q = s.nwg / NXCD, r = s.nwg % NXCD, xcd = w % NXCD, off = w / NXCD; return (xcd < r ? xcd * (q + 1) : r * (q + 1) + (xcd - r) * q) + off; }
    __device__ bool next(int i, Unit& u) const {
        if (!split) { if (sp == 0) { const bool ok = p4all.next(i, u); u.sel = 1; return ok; } if (sp == 1) return false; return p5all.next(i, u); }
        const int c = p4p.c;
        if (sp == 0) { if (i) return false; p4p.tile(swz(p4p, c), u); u.sel = 1; return true; }
        if (sp == 1) {
            if (c < 32) { if (i) return false; p4s.tile(swz(p4s, c), u); u.pm += 32; u.sel = 1; return true; }
            if (i > 1) return false; p5p.tile(swz(p5p, (c - 32) + 224 * i), u); return true; }
        const long J = (long)i * 256 + c; if (J >= 1136) return false;
        if (J < 960) p5p.tile(swz(p5p, 448 + J), u); else { p5s.tile(swz(p5s, J - 960), u); u.pm += 32; }
        return true;
    }
};

struct SplitTailOrder {
    StaticOrder p, all; int pass; bool split;
    __device__ bool next(int i, Unit& u) const {
        if (!split) return pass == 0 ? all.next(i, u) : false;
        if (i) return false;
        if (pass == 0) { p.tile(Ph45Order::swz(p, p.c), u); return true; }
        if (p.c >= 128) return false;
        const int tl = (p.c & 7) * 4 + (p.c >> 5), sp = (p.c >> 3) & 3;
        u.pm = 32 + (tl & 3); u.pn = tl >> 2; u.sel = 1 + tl; u.nkt = p.nkt / 4; u.kofs = sp * (p.nkt / 4); return true;
    }
};
template <class Epi, class Sched, bool DUAL = false>
__device__ __forceinline__ void gemm_phase(LAS unsigned char* lds, const Gemm g, const Sched& S, const Epi& E) {
    const int tid = threadIdx.x, wid = __builtin_amdgcn_readfirstlane(tid >> 6), lane = tid & 63, wr = wid >> 2, wc = wid & 3, fr = lane & 15, fq = lane >> 4;
    const int K = g.K;
    unsigned voffA[2], voffB[2];
#pragma unroll
    for (int i = 0; i < 2; ++i) { int R, C; stage_rc(tid * 16 + i * 8192, R, C); const int Rb = (R & ~31) + perm32(R & 31);
        voffA[i] = (unsigned)(R * K + C) * 2u; voffB[i] = (unsigned)(Rb * K + C) * 2u; }
    const size_t kstep = (size_t)(BK * 2);
    const size_t hstep = (size_t)HALF * K * 2;
    const size_t tstep = 2 * hstep;
    const unsigned ldsw = (unsigned)wid * 1024u;
    const int aoff = lds_byte(wr * 64 + fr, fq * 8), boff = lds_byte(wc * 32 + fr, fq * 8);
#define PG8_SA(b, h) (((b) * 2 + (h)) * HTB)
#define PG8_SB(b, h) ((4 + (b) * 2 + (h)) * HTB)
#define PG8_STAGE(bufoff, gbase, voff) do { _Pragma("unroll") for (int _i = 0; _i < 2; ++_i) \
        __builtin_amdgcn_global_load_lds((const unsigned*)((const char*)(gbase) + (voff)[_i]), (LAS unsigned*)(lds + (bufoff) + ldsw + _i * 8192), 16, 0, 0); } while (0)
#define PG8_LDA(dst, b, h) do { _Pragma("unroll") for (int m = 0; m < 4; ++m) _Pragma("unroll") for (int k = 0; k < 2; ++k) dst[m][k] = *(const LAS bf16x8*)(lds + PG8_SA(b, h) + aoff + m * 2048 + k * 1024); } while (0)
#define PG8_LDB(dst, b, h) do { _Pragma("unroll") for (int n = 0; n < 2; ++n) _Pragma("unroll") for (int k = 0; k < 2; ++k) dst[n][k] = *(const LAS bf16x8*)(lds + PG8_SB(b, h) + boff + n * 2048 + k * 1024); } while (0)
#define PG8_MMA(ai, bj, At, Bt) do { __builtin_amdgcn_s_setprio(1); _Pragma("unroll") for (int m = 0; m < 4; ++m) _Pragma("unroll") for (int n = 0; n < 2; ++n) _Pragma("unroll") for (int k = 0; k < 2; ++k) \
        acc[ai][bj][m][n] = __builtin_amdgcn_mfma_f32_16x16x32_bf16(Bt[n][k], At[m][k], acc[ai][bj][m][n], 0, 0, 0); __builtin_amdgcn_s_setprio(0); } while (0)
#define PG8_WAIT_V(n) asm volatile("s_waitcnt vmcnt(" #n ")" ::: "memory")
#define PG8_WAIT_L(n) asm volatile("s_waitcnt lgkmcnt(" #n ")" ::: "memory")
#define PG8_BAR __builtin_amdgcn_s_barrier()
#define PG8_SCHED __builtin_amdgcn_sched_barrier(0)
    Unit cur, nxt; int ui = 0;
    if (!S.next(0, cur)) return;
    f32x4 acc[2][2][4][2];
    E.init_acc(acc, cur, wr, wc, fr, fq);
    bf16x8 At[4][2], B0[2][2], B1[2][2];
    const char* cA = (const char*)((DUAL && cur.sel) ? g.A1 : g.A0) + (size_t)cur.pm * tstep + (size_t)cur.kofs * kstep; const char* cB = (const char*)((DUAL && cur.sel) ? g.B1 : g.B0) + (size_t)cur.pn * tstep + (size_t)cur.kofs * kstep;
    PG8_STAGE(PG8_SB(0, 0), cB, voffB); PG8_STAGE(PG8_SB(0, 1), cB + hstep, voffB); PG8_STAGE(PG8_SA(0, 0), cA, voffA); PG8_STAGE(PG8_SA(0, 1), cA + hstep, voffA);
    if (wr == 1) PG8_BAR;
    PG8_WAIT_V(2); PG8_BAR;
    PG8_STAGE(PG8_SB(1, 0), cB + kstep, voffB); PG8_STAGE(PG8_SA(1, 0), cA + kstep, voffA); PG8_STAGE(PG8_SB(1, 1), cB + hstep + kstep, voffB);
    PG8_WAIT_V(6); PG8_BAR;
    for (;;) {
        const bool has_next = S.next(ui + 1, nxt);
        const char* nA = has_next ? (const char*)((DUAL && nxt.sel) ? g.A1 : g.A0) + (size_t)nxt.pm * tstep + (size_t)nxt.kofs * kstep : cA; const char* nB = has_next ? (const char*)((DUAL && nxt.sel) ? g.B1 : g.B0) + (size_t)nxt.pn * tstep + (size_t)nxt.kofs * kstep : cB;
        const int nt = cur.nkt;
        for (int t = 0; t < nt; t += 2) {
            const bool last = (t == nt - 2);
            const char* a1 = cA + (size_t)(t + 1) * kstep;
            const char* a2 = last ? nA : cA + (size_t)(t + 2) * kstep; const char* b2 = last ? nB : cB + (size_t)(t + 2) * kstep;
            const char* a3 = a2 + kstep; const char* b3 = b2 + kstep;
            PG8_LDB(B0, 0, 0); PG8_LDB(B1, 0, 1); PG8_SCHED; PG8_LDA(At, 0, 0); PG8_STAGE(PG8_SA(1, 1), a1 + hstep, voffA);
            PG8_WAIT_V(8); PG8_WAIT_L(0); PG8_BAR; PG8_MMA(0, 0, At, B0); PG8_MMA(0, 1, At, B1); PG8_BAR; PG8_SCHED;
            PG8_LDA(At, 0, 1); PG8_STAGE(PG8_SB(0, 0), b2, voffB); PG8_STAGE(PG8_SB(0, 1), b2 + hstep, voffB); PG8_STAGE(PG8_SA(0, 0), a2, voffA);
            PG8_WAIT_V(8); PG8_WAIT_L(0); PG8_BAR; PG8_MMA(1, 0, At, B0); PG8_MMA(1, 1, At, B1); PG8_BAR; PG8_SCHED;
            PG8_LDB(B0, 1, 0); PG8_LDB(B1, 1, 1); PG8_SCHED; PG8_LDA(At, 1, 0); PG8_STAGE(PG8_SA(0, 1), a2 + hstep, voffA);
            PG8_WAIT_V(8); PG8_WAIT_L(0); PG8_BAR; PG8_MMA(0, 0, At, B0); PG8_MMA(0, 1, At, B1); PG8_BAR; PG8_SCHED;
            PG8_LDA(At, 1, 1); PG8_STAGE(PG8_SB(1, 0), b3, voffB); PG8_STAGE(PG8_SB(1, 1), b3 + hstep, voffB); PG8_STAGE(PG8_SA(1, 0), a3, voffA);
            PG8_WAIT_V(8); PG8_WAIT_L(0); PG8_BAR; PG8_MMA(1, 0, At, B0); PG8_MMA(1, 1, At, B1); PG8_BAR; PG8_SCHED;
        }
        if (wr == 0) PG8_BAR;
        { int fr_e = fr, fq_e = fq; asm volatile("" : "+v"(fr_e), "+v"(fq_e));
          E(acc, cur, wr, wc, fr_e, fq_e); }
        if (!has_next) break;
        if (!E.keep(cur)) { int fr_i = fr, fq_i = fq; asm volatile("" : "+v"(fr_i), "+v"(fq_i)); E.init_acc(acc, nxt, wr, wc, fr_i, fq_i); }
        cur = nxt; cA = nA; cB = nB; ++ui;
        if (wr == 1) PG8_BAR;
    }
    PG8_WAIT_V(0);
    PG8_BAR;
#undef PG8_SA
#undef PG8_SB
#undef PG8_STAGE
#undef PG8_LDA
#undef PG8_LDB
#undef PG8_MMA
#undef PG8_WAIT_V
#undef PG8_WAIT_L
#undef PG8_BAR
#undef PG8_SCHED
}
}

typedef f32x4 (&AccRef)[2][2][4][2];

__device__ __forceinline__ void acc_zero(AccRef acc) {
#pragma unroll
    for (int a = 0; a < 2; ++a)
#pragma unroll
        for (int b = 0; b < 2; ++b)
#pragma unroll
            for (int m = 0; m < 4; ++m)
#pragma unroll
                for (int n = 0; n < 2; ++n) acc[a][b][m][n] = (f32x4){0.f, 0.f, 0.f, 0.f};
}
__device__ __forceinline__ void acc_load(AccRef acc, const float* base, int rowt, int col0) {
#pragma unroll
    for (int ai = 0; ai < 2; ++ai)
#pragma unroll
        for (int m = 0; m < 4; ++m) { const float* rp = base + (size_t)(rowt + ai * 128 + m * 16) * DM + col0;
#pragma unroll
            for (int bj = 0; bj < 2; ++bj) { acc[ai][bj][m][0] = *(const f32x4*)(rp + bj * 128); acc[ai][bj][m][1] = *(const f32x4*)(rp + bj * 128 + 4); } }
}
template <int ACT>
__device__ __forceinline__ f32x4 act4(f32x4 v) {
    if (ACT == 1) return v * QSCALE;
    if (ACT == 2) return (f32x4){gelu_tanh_f(v[0]), gelu_tanh_f(v[1]), gelu_tanh_f(v[2]), gelu_tanh_f(v[3])};
    if (ACT == 3) return (f32x4){sigmoid_f(v[0]), sigmoid_f(v[1]), sigmoid_f(v[2]), sigmoid_f(v[3])};
    return v;
}
#define EPI_PIN(ai, m) f32x4 aq[2][2] = {{acc[ai][0][m][0], acc[ai][0][m][1]}, {acc[ai][1][m][0], acc[ai][1][m][1]}}; \
    asm volatile("" : "+v"(aq[0][0]), "+v"(aq[0][1]), "+v"(aq[1][0]), "+v"(aq[1][1]) :: "memory")
template <int ACT>
__device__ __forceinline__ void epi_store_bf16(AccRef acc, bf16_t* base, int ld, int rowt, int cw) {
#pragma unroll
    for (int ai = 0; ai < 2; ++ai)
#pragma unroll
        for (int m = 0; m < 4; ++m) { EPI_PIN(ai, m); bf16_t* rowp = base + (size_t)(rowt + ai * 128 + m * 16) * ld + cw;
#pragma unroll
            for (int bj = 0; bj < 2; ++bj) { const f32x4 v0 = act4<ACT>(aq[bj][0]), v1 = act4<ACT>(aq[bj][1]);
                u32x4 w; w.x = cvt_pk_bf16(v0[0], v0[1]); w.y = cvt_pk_bf16(v0[2], v0[3]); w.z = cvt_pk_bf16(v1[0], v1[1]); w.w = cvt_pk_bf16(v1[2], v1[3]);
                *(u32x4*)(rowp + bj * 128) = w; } }
}

struct Epi1 {
    bf16_t *Q, *Kb, *Vb, *U, *GV, *SA, *SB; float* stg; float* out;
    __device__ __forceinline__ void init_acc(AccRef acc, const pg8::Unit&, int, int, int, int) const { acc_zero(acc); }
    __device__ __forceinline__ bool keep(const pg8::Unit&) const { return false; }
    __device__ __forceinline__ void operator()(AccRef acc, const pg8::Unit& u, int wr, int wc, int fr, int fq) const {
        const int pn = u.pn, rowt = u.pm * 256 + wr * 64 + fr, cw = wc * 32 + 8 * fq;
        if (pn < 4) { epi_store_bf16<1>(acc, Q + pn * 256, QW, rowt, cw); }
        else if (pn < 6) {
            bf16_t* kb = (pn == 4) ? Kb : Vb;
            epi_store_bf16<0>(acc, kb, KVW, rowt, cw);
            if (u.pm >= 32) {
                float* ob = out + (pn == 4 ? O_SK : O_SV);
#pragma unroll
                for (int ai = 0; ai < 2; ++ai)
#pragma unroll
                    for (int m = 0; m < 4; ++m) { EPI_PIN(ai, m); const int r = rowt + ai * 128 + m * 16 - NPROMPT; const int sb = r >> 3, t = r & 7;
                        float* rowp = ob + ((size_t)sb * 128 + 120 + t) * 256 + cw;
#pragma unroll
                        for (int bj = 0; bj < 2; ++bj) { *(f32x4*)(rowp + bj * 128) = aq[bj][0]; *(f32x4*)(rowp + bj * 128 + 4) = aq[bj][1]; } }
            } else if ((u.pm & 7) == 7) {
                float* ob = out + (pn == 4 ? O_PK : O_PV);
#pragma unroll
                for (int m = 0; m < 4; ++m) { EPI_PIN(1, m); const int tw = wr * 64 + m * 16 + fr; float* rowp = ob + ((size_t)(u.pm >> 3) * 128 + tw) * 256 + cw;
#pragma unroll
                    for (int bj = 0; bj < 2; ++bj) { *(f32x4*)(rowp + bj * 128) = aq[bj][0]; *(f32x4*)(rowp + bj * 128 + 4) = aq[bj][1]; } }
            }
        }
        else if (pn < 10) { epi_store_bf16<2>(acc, U + (pn - 6) * 256, GW, rowt, cw); }
        else if (pn < 14) {
            bf16_t* base = GV + (pn - 10) * 256;
#pragma unroll
            for (int ai = 0; ai < 2; ++ai)
#pragma unroll
                for (int m = 0; m < 4; ++m) { EPI_PIN(ai, m); const int row = rowt + ai * 128 + m * 16; bf16_t* rowp = base + (size_t)row * GW + cw; float s = 0.f, q = 0.f;
#pragma unroll
                    for (int bj = 0; bj < 2; ++bj) { const f32x4 v0 = act4<2>(aq[bj][0]), v1 = act4<2>(aq[bj][1]);
                        s += (v0[0] + v0[1]) + (v0[2] + v0[3]) + (v1[0] + v1[1]) + (v1[2] + v1[3]);
                        q += (v0[0] * v0[0] + v0[1] * v0[1]) + (v0[2] * v0[2] + v0[3] * v0[3]) + (v1[0] * v1[0] + v1[1] * v1[1]) + (v1[2] * v1[2] + v1[3] * v1[3]);
                        u32x4 w; w.x = cvt_pk_bf16(v0[0], v0[1]); w.y = cvt_pk_bf16(v0[2], v0[3]); w.z = cvt_pk_bf16(v1[0], v1[1]); w.w = cvt_pk_bf16(v1[2], v1[3]);
                        *(u32x4*)(rowp + bj * 128) = w; }
                    s += __shfl_xor(s, 16); s += __shfl_xor(s, 32); q += __shfl_xor(q, 16); q += __shfl_xor(q, 32);
                    if (fq == 0) *(f32x2*)(stg + (size_t)row * 32 + ((pn - 10) * 4 + wc) * 2) = (f32x2){s, q}; }
        }
        else if (pn < 22) { epi_store_bf16<3>(acc, SA + (pn - 14) * 256, DM, rowt, cw); }
        else { epi_store_bf16<3>(acc, SB + (pn - 22) * 256, DM, rowt, cw); }
    }
};

struct Epi3 {
    const bf16_t *SA, *SB; bf16_t *MIXP, *MIXS;
    __device__ __forceinline__ void init_acc(AccRef acc, const pg8::Unit&, int, int, int, int) const { acc_zero(acc); }
    __device__ __forceinline__ bool keep(const pg8::Unit& u) const { return u.sel == 0; }
    __device__ __forceinline__ void operator()(AccRef acc, const pg8::Unit& u, int wr, int wc, int fr, int fq) const {
        const int rowt = u.pm * 256 + wr * 64 + fr, col0 = u.pn * 256 + wc * 32 + 8 * fq;
        bf16_t* MIX = (u.pm < 32) ? MIXP : MIXS;
#pragma unroll
        for (int ai = 0; ai < 2; ++ai) {
            u32x4 bw[4][2], aw[4][2];
#pragma unroll
            for (int m = 0; m < 4; ++m) { const size_t off = (size_t)(rowt + ai * 128 + m * 16) * DM + col0;
#pragma unroll
                for (int bj = 0; bj < 2; ++bj) { bw[m][bj] = *(const u32x4*)(SB + off + bj * 128); if (u.sel == 0) aw[m][bj] = *(const u32x4*)(SA + off + bj * 128); } }
#pragma unroll
            for (int m = 0; m < 4; ++m) { const size_t off = (size_t)(rowt + ai * 128 + m * 16) * DM + col0;
                asm volatile("" : "+v"(acc[ai][0][m][0]), "+v"(acc[ai][0][m][1]), "+v"(acc[ai][1][m][0]), "+v"(acc[ai][1][m][1]));
#pragma unroll
                for (int bj = 0; bj < 2; ++bj) { const u32x4 b4 = bw[m][bj];
                    f32x4 b0 = (f32x4){bf_lo(b4.x), bf_hi(b4.x), bf_lo(b4.y), bf_hi(b4.y)}, b1 = (f32x4){bf_lo(b4.z), bf_hi(b4.z), bf_lo(b4.w), bf_hi(b4.w)};
#pragma unroll
                    for (int j = 0; j < 4; ++j) { b0[j] = fmaxf(b0[j], 1e-20f); b1[j] = fmaxf(b1[j], 1e-20f); }
                    if (u.sel == 0) { const u32x4 a4 = aw[m][bj];
                        const f32x4 a0 = (f32x4){bf_lo(a4.x), bf_hi(a4.x), bf_lo(a4.y), bf_hi(a4.y)}, a1 = (f32x4){bf_lo(a4.z), bf_hi(a4.z), bf_lo(a4.w), bf_hi(a4.w)};
#pragma unroll
                        for (int j = 0; j < 4; ++j) { acc[ai][bj][m][0][j] *= a0[j] * fast_rcp(b0[j]); acc[ai][bj][m][1][j] *= a1[j] * fast_rcp(b1[j]); } }
                    else { const f32x4 v0 = b0 * acc[ai][bj][m][0], v1 = b1 * acc[ai][bj][m][1];
                        u32x4 w; w.x = cvt_pk_bf16(v0[0], v0[1]); w.y = cvt_pk_bf16(v0[2], v0[3]); w.z = cvt_pk_bf16(v1[0], v1[1]); w.w = cvt_pk_bf16(v1[2], v1[3]);
                        *(u32x4*)(MIX + off + bj * 128) = w; } }
                asm volatile("" : "+v"(acc[ai][0][m][0]), "+v"(acc[ai][0][m][1]), "+v"(acc[ai][1][m][0]), "+v"(acc[ai][1][m][1])); }
            asm volatile("" ::: "memory");
        }
    }
};

struct Epi4 {
    const float *xp, *xs, *g2; float* X1; bf16_t* XG; float* ss2;
    __device__ __forceinline__ void init_acc(AccRef acc, const pg8::Unit& u, int wr, int wc, int fr, int fq) const {
        acc_load(acc, (u.pm < 32) ? xp : (xs - (size_t)NPROMPT * DM), u.pm * 256 + wr * 64 + fr, u.pn * 256 + wc * 32 + 8 * fq); }
    __device__ __forceinline__ bool keep(const pg8::Unit&) const { return false; }
    __device__ __forceinline__ void operator()(AccRef acc, const pg8::Unit& u, int wr, int wc, int fr, int fq) const {
        const int rowt = u.pm * 256 + wr * 64 + fr, col0 = u.pn * 256 + wc * 32 + 8 * fq;
#pragma unroll
        for (int ai = 0; ai < 2; ++ai)
#pragma unroll
            for (int m = 0; m < 4; ++m) { EPI_PIN(ai, m); const int row = rowt + ai * 128 + m * 16; const size_t off = (size_t)row * DM + col0; float q = 0.f;
                f32x4 gv[2][2];
#pragma unroll
                for (int bj = 0; bj < 2; ++bj) { gv[bj][0] = *(const f32x4*)(g2 + col0 + bj * 128); gv[bj][1] = *(const f32x4*)(g2 + col0 + bj * 128 + 4); }
#pragma unroll
                for (int bj = 0; bj < 2; ++bj) { const f32x4 v0 = aq[bj][0], v1 = aq[bj][1];
                    *(f32x4*)(X1 + off + bj * 128) = v0; *(f32x4*)(X1 + off + bj * 128 + 4) = v1;
                    q += (v0[0] * v0[0] + v0[1] * v0[1]) + (v0[2] * v0[2] + v0[3] * v0[3]) + (v1[0] * v1[0] + v1[1] * v1[1]) + (v1[2] * v1[2] + v1[3] * v1[3]);
                    const f32x4 h0 = v0 * gv[bj][0], h1 = v1 * gv[bj][1];
                    u32x4 w; w.x = cvt_pk_bf16(h0[0], h0[1]); w.y = cvt_pk_bf16(h0[2], h0[3]); w.z = cvt_pk_bf16(h1[0], h1[1]); w.w = cvt_pk_bf16(h1[2], h1[3]);
                    *(u32x4*)(XG + off + bj * 128) = w; }
                q += __shfl_xor(q, 16); q += __shfl_xor(q, 32);
                if (fq == 0) ss2[(size_t)row * 32 + u.pn * 4 + wc] = q; }
    }
};

struct Epi5 {
    const float* ss2; bf16_t* ACT;
    __device__ __forceinline__ void init_acc(AccRef acc, const pg8::Unit&, int, int, int, int) const { acc_zero(acc); }
    __device__ __forceinline__ bool keep(const pg8::Unit&) const { return false; }
    __device__ __forceinline__ void operator()(AccRef acc, const pg8::Unit& u, int wr, int wc, int fr, int fq) const {
        const int rowt = u.pm * 256 + wr * 64 + fr, col0 = u.pn * 128 + wc * 32 + 8 * fq;
        float rs[8]; f32x4 pp[8][2];
#pragma unroll
        for (int r = 0; r < 8; ++r) { const float* sp = ss2 + (size_t)(rowt + (r >> 2) * 128 + (r & 3) * 16) * 32 + fq * 8; pp[r][0] = *(const f32x4*)sp; pp[r][1] = *(const f32x4*)(sp + 4); }
#pragma unroll
        for (int r = 0; r < 8; ++r) { float sm = (pp[r][0][0] + pp[r][0][1]) + (pp[r][0][2] + pp[r][0][3]) + (pp[r][1][0] + pp[r][1][1]) + (pp[r][1][2] + pp[r][1][3]);
            sm += __shfl_xor(sm, 16); sm += __shfl_xor(sm, 32); rs[r] = __builtin_amdgcn_rsqf(sm * (1.0f / DM) + EPS); }
        asm volatile("" ::: "memory");
#pragma unroll
        for (int ai = 0; ai < 2; ++ai)
#pragma unroll
            for (int m = 0; m < 4; ++m) { EPI_PIN(ai, m); const int row = rowt + ai * 128 + m * 16; const float rstd = rs[ai * 4 + m];
                f32x4 o[2];
#pragma unroll
                for (int n = 0; n < 2; ++n) { const f32x4 gt = aq[0][n] * rstd, up = aq[1][n] * rstd;
#pragma unroll
                    for (int j = 0; j < 4; ++j) o[n][j] = gt[j] * sigmoid_f(gt[j]) * up[j]; }
                u32x4 w; w.x = cvt_pk_bf16(o[0][0], o[0][1]); w.y = cvt_pk_bf16(o[0][2], o[0][3]); w.z = cvt_pk_bf16(o[1][0], o[1][1]); w.w = cvt_pk_bf16(o[1][2], o[1][3]);
                *(u32x4*)(ACT + (size_t)row * DFF + col0) = w; }
    }
};

struct Epi45 {
    Epi4 e4; Epi5 e5;
    __device__ __forceinline__ void init_acc(AccRef acc, const pg8::Unit& u, int wr, int wc, int fr, int fq) const { if (u.sel) e4.init_acc(acc, u, wr, wc, fr, fq); else acc_zero(acc); }
    __device__ __forceinline__ bool keep(const pg8::Unit&) const { return false; }
    __device__ __forceinline__ void operator()(AccRef acc, const pg8::Unit& u, int wr, int wc, int fr, int fq) const { if (u.sel) e4(acc, u, wr, wc, fr, fq); else e5(acc, u, wr, wc, fr, fq); }
};

struct Epi6 {
    float* Y; float* part;
    __device__ __forceinline__ void init_acc(AccRef acc, const pg8::Unit& u, int wr, int wc, int fr, int fq) const {
        if (u.sel == 0) acc_load(acc, Y, u.pm * 256 + wr * 64 + fr, u.pn * 256 + wc * 32 + 8 * fq); else acc_zero(acc); }
    __device__ __forceinline__ bool keep(const pg8::Unit&) const { return false; }
    __device__ __forceinline__ void operator()(AccRef acc, const pg8::Unit& u, int wr, int wc, int fr, int fq) const {
        const int rt = wr * 64 + fr, cw = wc * 32 + 8 * fq;
        float* pb = (u.sel == 0) ? Y + (size_t)u.pm * 256 * DM + u.pn * 256 : part + ((size_t)(u.kofs / u.nkt) * 32 + (u.sel - 1)) * 65536;
        const int ld = (u.sel == 0) ? DM : 256;
#pragma unroll
        for (int ai = 0; ai < 2; ++ai)
#pragma unroll
            for (int m = 0; m < 4; ++m) { EPI_PIN(ai, m); float* rowp = pb + (size_t)(rt + ai * 128 + m * 16) * ld + cw;
#pragma unroll
                for (int bj = 0; bj < 2; ++bj) { *(f32x4*)(rowp + bj * 128) = aq[bj][0]; *(f32x4*)(rowp + bj * 128 + 4) = aq[bj][1]; } }
    }
};

__device__ __forceinline__ void p0_transpose_item(const float* W, int K, int N, bf16_t* WT, int drow0, int k0, int n0, LAS float* scr, int lane) {
    const int kq = lane >> 4, n4 = (lane & 15) * 4;
    f32x4 v[16];
#pragma unroll
    for (int i = 0; i < 16; ++i) v[i] = __builtin_nontemporal_load((const f32x4*)(W + (size_t)(k0 + 4 * i + kq) * N + n0 + n4));
#pragma unroll
    for (int i = 0; i < 16; ++i) { LAS float* p = scr + (4 * i + kq) * 65 + n4; p[0] = v[i][0]; p[1] = v[i][1]; p[2] = v[i][2]; p[3] = v[i][3]; }
    asm volatile("s_waitcnt lgkmcnt(0)" ::: "memory");
    const int c = lane & 7;
#pragma unroll
    for (int j = 0; j < 8; ++j) { const int n = (lane >> 3) + 8 * j; const LAS float* s = scr + (8 * c) * 65 + n;
        u32x4 o; o.x = cvt_pk_bf16(s[0 * 65], s[1 * 65]); o.y = cvt_pk_bf16(s[2 * 65], s[3 * 65]); o.z = cvt_pk_bf16(s[4 * 65], s[5 * 65]); o.w = cvt_pk_bf16(s[6 * 65], s[7 * 65]);
        *(u32x4*)(WT + (size_t)(drow0 + n) * K + k0 + 8 * c) = o; }
    asm volatile("s_waitcnt lgkmcnt(0)" ::: "memory");
}

constexpr int KS_STRIDE = 144;
constexpr int VT_STRIDE = 528;
constexpr int ATT_VT_OFF = 256 * KS_STRIDE;

template <int NKT>
__device__ __forceinline__ void attn_tile(LAS const unsigned char* Ks, LAS const unsigned char* VT, bf16x8 q0, bf16x8 q1, int qi, int kt0, bool mask_prev, float sink2, bf16_t* optr, int lane) {
    const int l15 = lane & 15, quad = lane >> 4;
    bf16x8 qf[2]; qf[0] = q0; qf[1] = q1;
    LAS const unsigned char* Kw = Ks + kt0 * 16 * KS_STRIDE; LAS const unsigned char* Vw = VT + kt0 * 32;
    f32x4 s[NKT];
#pragma unroll
    for (int nt = 0; nt < NKT; ++nt) { s[nt] = (f32x4){0.f, 0.f, 0.f, 0.f}; if ((nt & 1) == 0) asm volatile("" ::: "memory");
#pragma unroll
        for (int ks = 0; ks < 2; ++ks) { const bf16x8 a = *(LAS const bf16x8*)(Kw + (nt * 16 + l15) * KS_STRIDE + ks * 64 + quad * 16);
            s[nt] = __builtin_amdgcn_mfma_f32_16x16x32_bf16(a, qf[ks], s[nt], 0, 0, 0); } }
    float mx = NEGBIG;
#pragma unroll
    for (int nt = 0; nt < NKT; ++nt) {
        if (mask_prev || nt < 2 || nt >= 8) {
#pragma unroll
            for (int j = 0; j < 4; ++j) { const int kidx = (kt0 + nt) * 16 + quad * 4 + j, diff = 128 + qi - kidx;
                const bool valid = (diff >= 0) && (diff <= 128) && !(mask_prev && kidx < 128);
                s[nt][j] = valid ? s[nt][j] : NEGBIG; } }
#pragma unroll
        for (int j = 0; j < 4; ++j) mx = fmaxf(mx, s[nt][j]); }
    mx = fmaxf(mx, __shfl_xor(mx, 16)); mx = fmaxf(mx, __shfl_xor(mx, 32)); mx = fmaxf(mx, sink2);
    float sum = 0.f;
#pragma unroll
    for (int nt = 0; nt < NKT; ++nt)
#pragma unroll
        for (int j = 0; j < 4; ++j) { const float p = fast_exp2(s[nt][j] - mx); s[nt][j] = p; sum += p; }
    sum += __shfl_xor(sum, 16); sum += __shfl_xor(sum, 32);
    const float inv = 1.0f / (sum + fast_exp2(sink2 - mx));
    f32x4 o[4];
#pragma unroll
    for (int mt = 0; mt < 4; ++mt) o[mt] = (f32x4){0.f, 0.f, 0.f, 0.f};
#pragma unroll
    for (int i = 0; i < NKT / 2; ++i) {
        asm volatile("" ::: "memory");
        u32x4 pw; pw.x = cvt_pk_bf16(s[2 * i][0], s[2 * i][1]); pw.y = cvt_pk_bf16(s[2 * i][2], s[2 * i][3]); pw.z = cvt_pk_bf16(s[2 * i + 1][0], s[2 * i + 1][1]); pw.w = cvt_pk_bf16(s[2 * i + 1][2], s[2 * i + 1][3]);
        const bf16x8 pb = __builtin_bit_cast(bf16x8, pw);
#pragma unroll
        for (int mt = 0; mt < 4; ++mt) { LAS const unsigned char* vp = Vw + (mt * 16 + l15) * VT_STRIDE + (32 * i + quad * 4) * 2;
            const s16x4 lo = *(LAS const s16x4*)vp, hi = *(LAS const s16x4*)(vp + 32);
            const bf16x8 a = (bf16x8){lo[0], lo[1], lo[2], lo[3], hi[0], hi[1], hi[2], hi[3]};
            o[mt] = __builtin_amdgcn_mfma_f32_16x16x32_bf16(a, pb, o[mt], 0, 0, 0); }
    }
#pragma unroll
    for (int mt = 0; mt < 4; ++mt) { const f32x4 v = o[mt] * inv; u32x2 w; w.x = cvt_pk_bf16(v[0], v[1]); w.y = cvt_pk_bf16(v[2], v[3]);
        *(u32x2*)(optr + mt * 16 + quad * 4) = w; }
}

#define XB_TMO      128
#define XB_XCNT(j)  (256  + 64 * (j))
#define XB_XSUB(j)  (1280 + 64 * (j))
#define XB_XGEN(j)  (2304 + 64 * (j))
#define XB_TOP      3328
#define XB_TOPGEN   3392
#define XCD_BAR_WORDS 3456
#define XB_SPIN_CAP (1u << 18)
__device__ __forceinline__ unsigned xb_ld(unsigned* p)              { return __hip_atomic_load(p, __ATOMIC_RELAXED, __HIP_MEMORY_SCOPE_AGENT); }
__device__ __forceinline__ unsigned xb_add(unsigned* p, unsigned v) { return __hip_atomic_fetch_add(p, v, __ATOMIC_RELAXED, __HIP_MEMORY_SCOPE_AGENT); }
__device__ __forceinline__ unsigned xb_xcc_id() { return (unsigned)__builtin_amdgcn_s_getreg((3 << 11) | 20) & 0xFu; }
#define XB_SPIN(cond, bar) do { unsigned _sp = 0; while (cond) { __builtin_amdgcn_s_sleep(1); \
    if ((++_sp & 255u) == 0u) { if (xb_ld(&(bar)[XB_TMO])) break; if (_sp > XB_SPIN_CAP) { atomicAdd(&(bar)[XB_TMO], 1u); break; } } } } while (0)
struct XcdBarrier { unsigned* bar; unsigned x; volatile LAS unsigned* st; };
__device__ __forceinline__ XcdBarrier xcd_barrier_post(unsigned* bar, volatile LAS unsigned* st) {
    XcdBarrier b; b.bar = bar; b.x = xb_xcc_id(); b.st = st;
    if (threadIdx.x == 0) (void)xb_add(&bar[XB_XCNT(b.x)], 1u);
    return b;
}
__device__ __forceinline__ void xcd_barrier_complete(unsigned* bar, unsigned x, unsigned& nloc, unsigned& nx) {
    const unsigned G = gridDim.x * gridDim.y * gridDim.z;
    unsigned sum, cnt, mine, sp = 0u;
    for (;;) {
        sum = 0u; cnt = 0u; mine = 0u;
#pragma unroll
        for (unsigned j = 0; j < 16; ++j) { const unsigned c = xb_ld(&bar[XB_XCNT(j)]); sum += c; cnt += (c > 0u) ? 1u : 0u; mine = (j == x) ? c : mine; }
        if (sum == G) break;
        __builtin_amdgcn_s_sleep(1);
        if ((++sp & 255u) == 0u) { if (xb_ld(&bar[XB_TMO])) break; if (sp > XB_SPIN_CAP) { atomicAdd(&bar[XB_TMO], 1u); break; } }
    }
    nloc = mine > 0u ? mine : 1u; nx = cnt > 0u ? cnt : 1u;
}
__device__ __forceinline__ void xcd_barrier(const XcdBarrier& b) {
    asm volatile("s_waitcnt vmcnt(0)" ::: "memory");
    __syncthreads();
    if (threadIdx.x == 0) {
        unsigned* bar = b.bar;
        __builtin_amdgcn_s_waitcnt(0);
        unsigned nloc = b.st[0], nx = b.st[1];
        if (nloc == 0u) { xcd_barrier_complete(bar, b.x, nloc, nx); b.st[0] = nloc; b.st[1] = nx; }
        const unsigned old = xb_add(&bar[XB_XSUB(b.x)], 1u);
        const unsigned gen = old / nloc;
        if (old + 1u == (gen + 1u) * nloc) {
            __builtin_amdgcn_fence(__ATOMIC_RELEASE, "agent");
            asm volatile("s_waitcnt vmcnt(0)" ::: "memory");
            const unsigned og = xb_add(&bar[XB_TOP], 1u);
            const unsigned tg = og / nx;
            if (og + 1u == (tg + 1u) * nx) xb_add(&bar[XB_TOPGEN], 1u);
            else XB_SPIN(xb_ld(&bar[XB_TOPGEN]) == tg, bar);
            __builtin_amdgcn_fence(__ATOMIC_ACQUIRE, "agent");
            xb_add(&bar[XB_XGEN(b.x)], 1u);
            asm volatile("s_waitcnt vmcnt(0)" ::: "memory");
        } else {
            XB_SPIN(xb_ld(&bar[XB_XGEN(b.x)]) == gen, bar);
            __builtin_amdgcn_fence(__ATOMIC_ACQUIRE, "agent");
            asm volatile("s_waitcnt vmcnt(0)" ::: "memory");
        }
    }
    __syncthreads();
}

struct Args { const float* in[18]; float* out; unsigned char* ws; int ph_lo, ph_hi; };

__global__ void __launch_bounds__(NWAVES * 64, 2) fwd_megakernel(Args args) {
    extern __shared__ __attribute__((aligned(16))) unsigned char lds_raw[];
    LAS unsigned char* lds = (LAS unsigned char*)lds_raw;
    cg::grid_group grid = cg::this_grid();
    const int tid = threadIdx.x, lane = tid & 63, wave = __builtin_amdgcn_readfirstlane(tid >> 6);
    const int G = gridDim.x, bx = blockIdx.x;
    unsigned char* ws = args.ws; float* out = args.out;
    const float *x_prompt = args.in[0], *x_sample = args.in[1], *cache_k = args.in[2], *cache_v = args.in[3], *norm1_g = args.in[4], *w_in = args.in[5], *gmlp_g = args.in[6],
                *w_s = args.in[7], *b_s = args.in[8], *sinks = args.in[9], *w_pa = args.in[10], *w_pb = args.in[11], *w_o = args.in[12], *norm2_g = args.in[13],
                *w_ffg = args.in[14], *w_ffu = args.in[15], *w_ffd = args.in[16], *final_g = args.in[17];
    bf16_t *WinT = (bf16_t*)(ws + WS_WIN), *WpaT = (bf16_t*)(ws + WS_WPA), *WpbT = (bf16_t*)(ws + WS_WPB), *WoT = (bf16_t*)(ws + WS_WO), *WguT = (bf16_t*)(ws + WS_WGU), *WdT = (bf16_t*)(ws + WS_WD);
    float *STG = (float*)(ws + WS_STG), *SS2 = (float*)(ws + WS_SS2), *SS3 = (float*)(ws + WS_SS3);
    bf16_t *Hb = (bf16_t*)(ws + WS_H), *ATT = (bf16_t*)(ws + WS_ATT), *GM = (bf16_t*)(ws + WS_GM), *XG = (bf16_t*)(ws + WS_XG);
    bf16_t *Qb = (bf16_t*)(ws + WS_Q), *Kb = (bf16_t*)(ws + WS_K), *Vb = (bf16_t*)(ws + WS_V), *Ub = (bf16_t*)(ws + WS_U), *GVb = (bf16_t*)(ws + WS_GV), *MIX = (bf16_t*)(ws + WS_MIX);
    bf16_t* MIXS = (bf16_t*)(ws + WS_WIN) - (size_t)NPROMPT * DM;
    bf16_t *SAb = (bf16_t*)(out + O_Y), *SBb = SAb + (size_t)MROWS * DM, *ACT = (bf16_t*)(ws + WS_ACT);

    const int lo = args.ph_lo, hi = args.ph_hi;
#ifndef PHASE_MASK
#define PHASE_MASK 255
#endif
#define IN(k) (((PHASE_MASK >> (k)) & 1) && lo <= (k) && (k) < hi)
#define SEAM(k) do { if (IN(k) && IN((k) + 1)) xcd_barrier(xbar); } while (0)
    volatile LAS unsigned* xb_st = (volatile LAS unsigned*)(lds + XB_LDS_OFF);
    if (tid < 2) xb_st[tid] = 0u;
    __syncthreads();
    const XcdBarrier xbar = xcd_barrier_post((unsigned*)ws, xb_st);
    if (hi > 1000) grid.sync();
    const int gw = bx * NWAVES + wave, NGW = G * NWAVES;

    if (IN(0)) {
        LAS float* scr = (LAS float*)(lds + wave * 16640);
        constexpr int I_IN = 32 * 120;
        for (int it = gw; it < I_IN; it += NGW) { const int kb = it / 120, nb = it % 120; p0_transpose_item(w_in, DM, INW, WinT, 64 * nb, 64 * kb, 64 * nb, scr, lane); }
        for (int m = gw; m < MROWS; m += NGW) {
            const float* xr = (m < NPROMPT) ? x_prompt + (size_t)m * DM : x_sample + (size_t)(m - NPROMPT) * DM;
            f32x4 v[8]; float ss = 0.f;
#pragma unroll
            for (int j = 0; j < 8; ++j) { v[j] = __builtin_nontemporal_load((const f32x4*)(xr + (j * 64 + lane) * 4)); ss += (v[j][0] * v[j][0] + v[j][1] * v[j][1]) + (v[j][2] * v[j][2] + v[j][3] * v[j][3]); }
            const float rstd = __builtin_amdgcn_rsqf(wave_sum(ss) * (1.0f / DM) + EPS);
#pragma unroll
            for (int j = 0; j < 8; ++j) { const f32x4 gg = *(const f32x4*)(norm1_g + (j * 64 + lane) * 4); const f32x4 h = v[j] * rstd * gg;
                u32x2 w; w.x = cvt_pk_bf16(h[0], h[1]); w.y = cvt_pk_bf16(h[2], h[3]); *(u32x2*)(Hb + (size_t)m * DM + (j * 64 + lane) * 4) = w; }
        }
    }
    SEAM(0);

    const bool p1_split = (G == 256);
    const int p1_full = p1_split ? 4 : (1 << 20), p1_tail = p1_split ? 56 : 0;
    if (IN(1)) {
        pg8::Gemm g{Hb, WinT, Hb, WinT, MROWS, INW, DM}; pg8::P1Order S; S.a.init(MROWS, 14 * 256, DM, G, bx); S.b.init(MROWS, 16 * 256, DM, G, bx); S.lo = 0; S.hi = p1_full;
        Epi1 E{Qb, Kb, Vb, Ub, GVb, SAb, SBb, STG, out};
        pg8::gemm_phase<Epi1, pg8::P1Order>(lds, g, S, E);
    }
    SEAM(1);

    if (IN(2)) {
        int nitems, rank = bx - p1_tail; const bool tailwg = p1_split && bx < p1_tail;
        if (!p1_split) nitems = (1408 - bx + G - 1) / G;
        else if (tailwg) { nitems = (1408 - 1224 - bx + p1_tail - 1) / p1_tail;
            pg8::Gemm g{Hb, WinT, Hb, WinT, MROWS, INW, DM}; pg8::P1Order S; S.a.init(MROWS, 14 * 256, DM, G, bx); S.b.init(MROWS, 16 * 256, DM, G, bx); S.lo = p1_full; S.hi = p1_full + 1;
            Epi1 E{Qb, Kb, Vb, Ub, GVb, SAb, SBb, STG, out};
            pg8::gemm_phase<Epi1, pg8::P1Order>(lds, g, S, E); }
        else nitems = (rank < 56) ? 4 : 8;
        int ws_g = -1;
        for (int k = 0; k < nitems; ++k) {
            int it;
            if (!p1_split) it = bx + k * G;
            else if (tailwg) it = 1224 + bx + k * p1_tail;
            else if (rank < 56) it = (k < 2) ? rank + 200 * k : 256 + rank + 56 * (k - 2);
            else { const int r2 = rank - 56;
                if (k == 0) it = rank;
                else if (k < 4) { it = 256 + 112 + r2 + 144 * (k - 1); if (it >= 768) it = -1; }
                else { it = 768 + r2 + 144 * (k - 4); if (it >= 1224) it = -1; } }
            if (it < 0) continue;
            if (it < 256) {
                const int b = it >> 6, n = (it >> 2) & 15, h = it & 3; ws_g = -1;
                LAS unsigned char* Ks = lds; LAS unsigned char* VT = lds + ATT_VT_OFF;
                const int r = wave >> 1, head = h * 4 + r; const float sink2 = sinks[head] * LOG2E;
                const bf16_t* qbase = Qb + (size_t)(b * SEQ + n * 128 + (wave & 1) * 64 + (lane & 15)) * QW + head * 64 + (lane >> 4) * 8;
                bf16x8 qc0 = *(const bf16x8*)qbase, qc1 = *(const bf16x8*)(qbase + 32);
#pragma unroll
                for (int p = 0; p < 4; ++p) { const int key = p * 64 + (tid >> 3), chunk = tid & 7, pos = (n - 1) * 128 + key;
                    u32x4 v = (u32x4){0u, 0u, 0u, 0u}; if (pos >= 0) v = *(const u32x4*)(Kb + (size_t)(b * SEQ + pos) * KVW + h * 64 + chunk * 8);
                    *(LAS u32x4*)(Ks + key * KS_STRIDE + chunk * 16) = v; }
#pragma unroll
                for (int p = 0; p < 4; ++p) { const int idx = p * 512 + tid, key = idx & 255, chunk = idx >> 8, pos = (n - 1) * 128 + key;
                    u32x4 v = (u32x4){0u, 0u, 0u, 0u}; if (pos >= 0) v = *(const u32x4*)(Vb + (size_t)(b * SEQ + pos) * KVW + h * 64 + chunk * 8);
                    LAS unsigned short* vt = (LAS unsigned short*)(VT + (chunk * 8) * VT_STRIDE + key * 2);
                    vt[0 * (VT_STRIDE / 2)] = (unsigned short)(v.x & 0xffff); vt[1 * (VT_STRIDE / 2)] = (unsigned short)(v.x >> 16);
                    vt[2 * (VT_STRIDE / 2)] = (unsigned short)(v.y & 0xffff); vt[3 * (VT_STRIDE / 2)] = (unsigned short)(v.y >> 16);
                    vt[4 * (VT_STRIDE / 2)] = (unsigned short)(v.z & 0xffff); vt[5 * (VT_STRIDE / 2)] = (unsigned short)(v.z >> 16);
                    vt[6 * (VT_STRIDE / 2)] = (unsigned short)(v.w & 0xffff); vt[7 * (VT_STRIDE / 2)] = (unsigned short)(v.w >> 16); }
                __syncthreads();
#pragma unroll 1
                for (int mt = 0; mt < 4; ++mt) { const int qt = (wave & 1) * 4 + mt, qi = qt * 16 + (lane & 15); const size_t qoff = (size_t)(b * SEQ + n * 128 + qi) * QW + head * 64;
                    const bf16_t* qn = qbase + (size_t)(mt < 3 ? mt + 1 : 3) * 16 * QW; const bf16x8 qn0 = *(const bf16x8*)qn, qn1 = *(const bf16x8*)(qn + 32);
                    attn_tile<10>(Ks, VT, qc0, qc1, qi, qt < 6 ? qt : 6, n == 0, sink2, ATT + qoff, lane);
                    qc0 = qn0; qc1 = qn1; }
                asm volatile("s_waitcnt lgkmcnt(0)\n\ts_barrier" ::: "memory");
            } else if (it < 768) {
                const int id = it - 256, g = id & 7, c = (id >> 3) & 15, b = id >> 7; const int R0 = b * SEQ + c * 128;
                LAS unsigned char* wsL = lds; LAS unsigned char* vnT = lds + 34816; LAS float* stat = (LAS float*)(lds + 69632);
                u32x4 gvv[4];
#pragma unroll
                for (int p = 0; p < 4; ++p) { const int idx = p * 512 + tid, s_ = idx & 127, dc = idx >> 7; gvv[p] = *(const u32x4*)(GVb + (size_t)(R0 + s_) * GW + g * 128 + dc * 8); }
                if (tid < 128) { const float* sp = STG + (size_t)(R0 + tid) * 32; float s = 0.f, q = 0.f;
#pragma unroll
                    for (int j = 0; j < 8; ++j) { const f32x4 v = *(const f32x4*)(sp + 4 * j); s += v[0] + v[2]; q += v[1] + v[3]; }
                    const float mean = s * (1.0f / GW), var = fmaxf(q * (1.0f / GW) - mean * mean, 0.f);
                    stat[2 * tid] = mean; stat[2 * tid + 1] = __builtin_amdgcn_rsqf(var + EPS); }
                if (ws_g != g) { ws_g = g;
#pragma unroll
                for (int p = 0; p < 8; ++p) { const int idx = p * 512 + tid, t = idx >> 5, s4 = (idx & 31) * 4; const f32x4 w = *(const f32x4*)(w_s + ((size_t)g * 128 + t) * 128 + s4);
                    u32x2 o; o.x = cvt_pk_bf16(s4 + 0 <= t ? w[0] : 0.f, s4 + 1 <= t ? w[1] : 0.f); o.y = cvt_pk_bf16(s4 + 2 <= t ? w[2] : 0.f, s4 + 3 <= t ? w[3] : 0.f);
                    *(LAS u32x2*)(wsL + t * 272 + s4 * 2) = o; } }
                __syncthreads();
#pragma unroll
                for (int p = 0; p < 4; ++p) { const int idx = p * 512 + tid, s = idx & 127, dc = idx >> 7; const u32x4 v = gvv[p];
                    const float mean = stat[2 * s], rstd = stat[2 * s + 1]; const f32x4 ga = *(const f32x4*)(gmlp_g + g * 128 + dc * 8), gb = *(const f32x4*)(gmlp_g + g * 128 + dc * 8 + 4);
                    LAS unsigned short* vt = (LAS unsigned short*)(vnT + (dc * 8) * 272 + s * 2);
                    const unsigned w0 = cvt_pk_bf16((bf_lo(v.x) - mean) * rstd * ga[0], (bf_hi(v.x) - mean) * rstd * ga[1]), w1 = cvt_pk_bf16((bf_lo(v.y) - mean) * rstd * ga[2], (bf_hi(v.y) - mean) * rstd * ga[3]);
                    const unsigned w2 = cvt_pk_bf16((bf_lo(v.z) - mean) * rstd * gb[0], (bf_hi(v.z) - mean) * rstd * gb[1]), w3 = cvt_pk_bf16((bf_lo(v.w) - mean) * rstd * gb[2], (bf_hi(v.w) - mean) * rstd * gb[3]);
                    vt[0 * 136] = (unsigned short)(w0 & 0xffff); vt[1 * 136] = (unsigned short)(w0 >> 16); vt[2 * 136] = (unsigned short)(w1 & 0xffff); vt[3 * 136] = (unsigned short)(w1 >> 16);
                    vt[4 * 136] = (unsigned short)(w2 & 0xffff); vt[5 * 136] = (unsigned short)(w2 >> 16); vt[6 * 136] = (unsigned short)(w3 & 0xffff); vt[7 * 136] = (unsigned short)(w3 >> 16); }
                __syncthreads();
                {
                    const int l15 = lane & 15, quad = lane >> 4;
                    f32x4 acc[8];
#pragma unroll
                    for (int dt = 0; dt < 8; ++dt) acc[dt] = (f32x4){0.f, 0.f, 0.f, 0.f};
                    const int ksmax = wave >> 1;
                    const int t = wave * 16 + l15; const float bias = b_s[g * 128 + t]; const size_t off = (size_t)(R0 + t) * GW + g * 128 + quad * 4;
                    u32x2 uw[8];
#pragma unroll
                    for (int dt = 0; dt < 8; ++dt) uw[dt] = *(const u32x2*)(Ub + off + dt * 16);
#pragma unroll 1
                    for (int ks = 0; ks <= ksmax; ++ks) { const bf16x8 a = *(LAS const bf16x8*)(wsL + (wave * 16 + l15) * 272 + ks * 64 + quad * 16);
#pragma unroll
                        for (int dt = 0; dt < 8; ++dt) { const bf16x8 bb = *(LAS const bf16x8*)(vnT + (dt * 16 + l15) * 272 + ks * 64 + quad * 16);
                            acc[dt] = __builtin_amdgcn_mfma_f32_16x16x32_bf16(bb, a, acc[dt], 0, 0, 0); } }
#pragma unroll
                    for (int dt = 0; dt < 8; ++dt) { u32x2 w; w.x = cvt_pk_bf16(bf_lo(uw[dt].x) * (acc[dt][0] + bias), bf_hi(uw[dt].x) * (acc[dt][1] + bias));
                        w.y = cvt_pk_bf16(bf_lo(uw[dt].y) * (acc[dt][2] + bias), bf_hi(uw[dt].y) * (acc[dt][3] + bias)); *(u32x2*)(GM + off + dt * 16) = w; }
                }
                asm volatile("s_waitcnt lgkmcnt(0)\n\ts_barrier" ::: "memory");
            } else if (it < 1280) {
                const int id = it - 768, b = id >> 2, h = id & 3; ws_g = -1;
                LAS unsigned char* Ks = lds; LAS unsigned char* VT = lds + ATT_VT_OFF;
                const int sl15 = lane & 15, st = sl15 & 7, shead = h * 4 + 2 * (wave & 1) + (sl15 >> 3); const size_t sqoff = (size_t)(NPROMPT + b * 8 + st) * QW + shead * 64;
                const bf16x8 sq0 = *(const bf16x8*)(Qb + sqoff + (lane >> 4) * 8), sq1 = *(const bf16x8*)(Qb + sqoff + 32 + (lane >> 4) * 8);
                { const int key = tid >> 2, part = tid & 3; const float* src = cache_k + ((size_t)(b * 128 + key) * 4 + h) * 64 + part * 16;
                    const f32x4 a0 = *(const f32x4*)src, a1 = *(const f32x4*)(src + 4), a2 = *(const f32x4*)(src + 8), a3 = *(const f32x4*)(src + 12);
                    u32x4 w0, w1; w0.x = cvt_pk_bf16(a0[0], a0[1]); w0.y = cvt_pk_bf16(a0[2], a0[3]); w0.z = cvt_pk_bf16(a1[0], a1[1]); w0.w = cvt_pk_bf16(a1[2], a1[3]);
                    w1.x = cvt_pk_bf16(a2[0], a2[1]); w1.y = cvt_pk_bf16(a2[2], a2[3]); w1.z = cvt_pk_bf16(a3[0], a3[1]); w1.w = cvt_pk_bf16(a3[2], a3[3]);
                    *(LAS u32x4*)(Ks + key * KS_STRIDE + part * 32) = w0; *(LAS u32x4*)(Ks + key * KS_STRIDE + part * 32 + 16) = w1; }
                if (tid < 64) { const int key = 128 + (tid >> 3), chunk = tid & 7; *(LAS u32x4*)(Ks + key * KS_STRIDE + chunk * 16) = *(const u32x4*)(Kb + (size_t)(NPROMPT + b * 8 + (tid >> 3)) * KVW + h * 64 + chunk * 8); }
                else if (tid < 256) { const int key = 136 + ((tid - 64) >> 3), chunk = (tid - 64) & 7; *(LAS u32x4*)(Ks + key * KS_STRIDE + chunk * 16) = (u32x4){0u, 0u, 0u, 0u}; }
                { const int key = tid & 127, part = tid >> 7; const float* src = cache_v + ((size_t)(b * 128 + key) * 4 + h) * 64 + part * 16;
                    LAS unsigned short* vt = (LAS unsigned short*)(VT + (part * 16) * VT_STRIDE + key * 2);
#pragma unroll
                    for (int q4 = 0; q4 < 4; ++q4) { const f32x4 a = *(const f32x4*)(src + 4 * q4); const unsigned w0 = cvt_pk_bf16(a[0], a[1]), w1 = cvt_pk_bf16(a[2], a[3]);
                        vt[(4 * q4 + 0) * (VT_STRIDE / 2)] = (unsigned short)(w0 & 0xffff); vt[(4 * q4 + 1) * (VT_STRIDE / 2)] = (unsigned short)(w0 >> 16);
                        vt[(4 * q4 + 2) * (VT_STRIDE / 2)] = (unsigned short)(w1 & 0xffff); vt[(4 * q4 + 3) * (VT_STRIDE / 2)] = (unsigned short)(w1 >> 16); } }
                if (tid < 64) { const int key = 128 + (tid & 7), chunk = tid >> 3; const u32x4 v = *(const u32x4*)(Vb + (size_t)(NPROMPT + b * 8 + (tid & 7)) * KVW + h * 64 + chunk * 8);
                    LAS unsigned short* vt = (LAS unsigned short*)(VT + (chunk * 8) * VT_STRIDE + key * 2);
                    vt[0 * (VT_STRIDE / 2)] = (unsigned short)(v.x & 0xffff); vt[1 * (VT_STRIDE / 2)] = (unsigned short)(v.x >> 16);
                    vt[2 * (VT_STRIDE / 2)] = (unsigned short)(v.y & 0xffff); vt[3 * (VT_STRIDE / 2)] = (unsigned short)(v.y >> 16);
                    vt[4 * (VT_STRIDE / 2)] = (unsigned short)(v.z & 0xffff); vt[5 * (VT_STRIDE / 2)] = (unsigned short)(v.z >> 16);
                    vt[6 * (VT_STRIDE / 2)] = (unsigned short)(v.w & 0xffff); vt[7 * (VT_STRIDE / 2)] = (unsigned short)(v.w >> 16); }
                for (int idx = tid; idx < 24 * 64; idx += 512) { const int d = idx / 24, key = 136 + idx % 24; *(LAS unsigned short*)(VT + d * VT_STRIDE + key * 2) = 0; }
                __syncthreads();
                if (wave < 2) attn_tile<10>(Ks, VT, sq0, sq1, st, 0, false, sinks[shead] * LOG2E, ATT + sqoff, lane);
                asm volatile("s_waitcnt lgkmcnt(0)\n\ts_barrier" ::: "memory");
            } else {
                const int b = it - 1280, R0 = NPROMPT + b * 8; ws_g = -1;
                LAS float* stat = (LAS float*)lds;
                const int c = 2 * tid, g = wave;
                unsigned gvw[8], uw[8];
#pragma unroll
                for (int s_ = 0; s_ < 8; ++s_) { gvw[s_] = *(const unsigned*)(GVb + (size_t)(R0 + s_) * GW + c); uw[s_] = *(const unsigned*)(Ub + (size_t)(R0 + s_) * GW + c); }
                const f32x2 gam = *(const f32x2*)(gmlp_g + c);
                if (tid < 8) { const float* sp = STG + (size_t)(R0 + tid) * 32; float sm = 0.f, q = 0.f;
#pragma unroll
                    for (int j2 = 0; j2 < 8; ++j2) { const f32x4 v = *(const f32x4*)(sp + 4 * j2); sm += v[0] + v[2]; q += v[1] + v[3]; }
                    const float mean = sm * (1.0f / GW), var = fmaxf(q * (1.0f / GW) - mean * mean, 0.f);
                    stat[2 * tid] = mean; stat[2 * tid + 1] = __builtin_amdgcn_rsqf(var + EPS); }
                __syncthreads();
                float vn0[8], vn1[8];
#pragma unroll
                for (int s_ = 0; s_ < 8; ++s_) { const float mean = stat[2 * s_], rstd = stat[2 * s_ + 1];
                    vn0[s_] = (bf_lo(gvw[s_]) - mean) * rstd * gam[0]; vn1[s_] = (bf_hi(gvw[s_]) - mean) * rstd * gam[1];
                    *(f32x2*)(out + O_SG + (size_t)(b * 8 + s_) * GW + c) = (f32x2){vn0[s_], vn1[s_]}; }
#pragma unroll
                for (int t = 0; t < 8; ++t) { float m0 = b_s[g * 128 + t], m1 = m0;
#pragma unroll
                    for (int s_ = 0; s_ < 8; ++s_) if (s_ <= t) { const float w = w_s[((size_t)g * 128 + t) * 128 + s_]; m0 += w * vn0[s_]; m1 += w * vn1[s_]; }
                    *(unsigned*)(GM + (size_t)(R0 + t) * GW + c) = cvt_pk_bf16(bf_lo(uw[t]) * m0, bf_hi(uw[t]) * m1); }
                asm volatile("s_waitcnt lgkmcnt(0)\n\ts_barrier" ::: "memory");
            }
        }
        {
            const int rank = p1_split ? bx : bx, cnt = p1_split ? p1_tail : G;
            if (!p1_split || bx < p1_tail) { LAS float* scr = (LAS float*)(lds + wave * 16640);
                for (int it = rank * NWAVES + wave; it < 2 * 16 * 32; it += cnt * NWAVES) { const int r = it & 511, kb = r / 32, nb = r % 32;
                    if (it < 512) p0_transpose_item(w_pa, GW, DM, WpaT, 64 * nb, 64 * kb, 64 * nb, scr, lane); else p0_transpose_item(w_pb, QW, DM, WpbT, 64 * nb, 64 * kb, 64 * nb, scr, lane); } }
        }
    }
    SEAM(2);

    if (IN(3)) {
        pg8::Gemm g{GM, WpaT, ATT, WpbT, MROWS, DM, GW}; pg8::DualOrder S; S.b.init(MROWS, DM, GW, G, bx);
        Epi3 E{SAb, SBb, MIX, MIXS};
        pg8::gemm_phase<Epi3, pg8::DualOrder, true>(lds, g, S, E);
        const int rem = S.b.nwg % G, cnt = rem ? G - rem : G, rank = rem ? bx - rem : bx;
        if (rank >= 0) {
            LAS float* scr = (LAS float*)(lds + wave * 16640);
            constexpr int I_O = 32 * 32, I_FF = 32 * 88, NIT = I_O + 2 * I_FF;
            for (int it = rank * NWAVES + wave; it < NIT; it += cnt * NWAVES) {
                int r = it;
                if (r < I_O) { const int kb = r / 32, nb = r % 32; p0_transpose_item(w_o, DM, DM, WoT, 64 * nb, 64 * kb, 64 * nb, scr, lane); continue; } r -= I_O;
                if (r < I_FF) { const int kb = r / 88, nb = r % 88, n0 = 64 * nb; p0_transpose_item(w_ffg, DM, DFF, WguT, 256 * (n0 >> 7) + (n0 & 127), 64 * kb, n0, scr, lane); continue; } r -= I_FF;
                { const int kb = r / 88, nb = r % 88, n0 = 64 * nb; p0_transpose_item(w_ffu, DM, DFF, WguT, 256 * (n0 >> 7) + 128 + (n0 & 127), 64 * kb, n0, scr, lane); }
            }
        }
    }
    SEAM(3);

    if (IN(4)) {
        const bool split45 = (G == 256);
#pragma unroll 1
        for (int sp = 0; sp < 3; ++sp) {
            pg8::Ph45Order S; S.p4p.init(NPROMPT, DM, DM, G, bx); S.p4s.init(NSAMPLE, DM, DM, G, bx); S.p5p.init(NPROMPT, 2 * DFF, DM, G, bx); S.p5s.init(NSAMPLE, 2 * DFF, DM, G, bx);
            S.p4all.init(MROWS, DM, DM, G, bx); S.p5all.init(MROWS, 2 * DFF, DM, G, bx); S.sp = sp; S.split = split45;
            pg8::Gemm g{XG, WguT, (sp == 1 && split45) ? MIXS : MIX, WoT, MROWS, 0, DM};
            Epi45 E{Epi4{x_prompt, x_sample, norm2_g, out + O_Y, XG, SS2}, Epi5{SS2, ACT}};
            pg8::gemm_phase<Epi45, pg8::Ph45Order, true>(lds, g, S, E);
            if (sp == 2) {
                const int rank = split45 ? bx - 112 : bx, cnt = split45 ? 144 : G;
                if (rank >= 0) { LAS float* scr = (LAS float*)(lds + wave * 16640);
                    for (int it = rank * NWAVES + wave; it < 88 * 32; it += cnt * NWAVES) { const int kb = it / 32, nb = it % 32; p0_transpose_item(w_ffd, DFF, DM, WdT, 64 * nb, 64 * kb, 64 * nb, scr, lane); }
                    const int NV = DECB * 120 * 64;
                    for (int i0 = rank * 2048 + tid; i0 < 2 * NV; i0 += cnt * 2048) { f32x4 t[4]; float* dp[4];
#pragma unroll
                        for (int q = 0; q < 4; ++q) { const int i = i0 + q * 512; const int which = i >= NV, r = which ? i - NV : i; const int sb = r / (120 * 64), rem2 = r % (120 * 64);
                            t[q] = __builtin_nontemporal_load((const f32x4*)((which ? cache_v : cache_k) + (size_t)sb * 128 * 256 + 8 * 256 + rem2 * 4));
                            dp[q] = out + (which ? O_SV : O_SK) + (size_t)sb * 128 * 256 + rem2 * 4; }
#pragma unroll
                        for (int q = 0; q < 4; ++q) *(f32x4*)dp[q] = t[q]; } }
            }
            if (sp < 2) xcd_barrier(xbar);
        }
    }
    SEAM(5);

    if (IN(6)) {
        const bool split6 = (G == 256);
        int lane6 = threadIdx.x; asm volatile("" : "+v"(lane6)); lane6 &= 63;
        const float* part = (const float*)(ws + WS_PART);
        {
            pg8::Gemm g{ACT, WdT, ACT, WdT, MROWS, DM, DFF}; pg8::SplitTailOrder S; S.p.init(NPROMPT, DM, DFF, G, bx); S.all.init(MROWS, DM, DFF, G, bx); S.pass = 0; S.split = split6;
            Epi6 E{out + O_Y, (float*)(ws + WS_PART)};
            pg8::gemm_phase<Epi6, pg8::SplitTailOrder>(lds, g, S, E);
        }
        xcd_barrier(xbar);
        if (split6 && bx < 128) {
            pg8::Gemm g{ACT, WdT, ACT, WdT, MROWS, DM, DFF}; pg8::SplitTailOrder S; S.p.init(NPROMPT, DM, DFF, G, bx); S.all.init(MROWS, DM, DFF, G, bx); S.pass = 1; S.split = true;
            Epi6 E{out + O_Y, (float*)(ws + WS_PART)};
            pg8::gemm_phase<Epi6, pg8::SplitTailOrder>(lds, g, S, E);
        } else if (split6) {
            for (int m = (bx - 128) * NWAVES + wave; m < NPROMPT; m += 128 * NWAVES) {
                float* yr = out + O_Y + (size_t)m * DM; f32x4 v[8]; float ss = 0.f;
#pragma unroll
                for (int j = 0; j < 8; ++j) { v[j] = *(const f32x4*)(yr + (j * 64 + lane6) * 4); ss += (v[j][0] * v[j][0] + v[j][1] * v[j][1]) + (v[j][2] * v[j][2] + v[j][3] * v[j][3]); }
                const float rstd = __builtin_amdgcn_rsqf(wave_sum(ss) * (1.0f / DM) + EPS);
#pragma unroll
                for (int j = 0; j < 8; ++j) { const f32x4 gg = *(const f32x4*)(final_g + (j * 64 + lane6) * 4); *(f32x4*)(yr + (j * 64 + lane6) * 4) = v[j] * rstd * gg; }
            }
        }
        xcd_barrier(xbar);
        for (int m = (split6 ? NPROMPT : 0) + gw; m < MROWS; m += NGW) {
            float* yr = out + O_Y + (size_t)m * DM; f32x4 v[8]; float ss = 0.f;
#pragma unroll
            for (int j = 0; j < 8; ++j) v[j] = *(const f32x4*)(yr + (j * 64 + lane6) * 4);
            if (split6) {
#pragma unroll
                for (int j = 0; j < 8; ++j) { const int tl = j * 4 + ((m >> 8) - 32); if ((j & 1) == 0) asm volatile("" ::: "memory");
#pragma unroll
                    for (int sp = 0; sp < 4; ++sp) v[j] += *(const f32x4*)(part + ((size_t)sp * 32 + tl) * 65536 + (size_t)(m & 255) * 256 + lane6 * 4); } }
#pragma unroll
            for (int j = 0; j < 8; ++j) ss += (v[j][0] * v[j][0] + v[j][1] * v[j][1]) + (v[j][2] * v[j][2] + v[j][3] * v[j][3]);
            const float rstd = __builtin_amdgcn_rsqf(wave_sum(ss) * (1.0f / DM) + EPS);
#pragma unroll
            for (int j = 0; j < 8; ++j) { const f32x4 gg = *(const f32x4*)(final_g + (j * 64 + lane6) * 4); *(f32x4*)(yr + (j * 64 + lane6) * 4) = v[j] * rstd * gg; }
        }
    }
#undef IN
#undef SEAM
}

extern "C" void kernel_launch(void* const* d_in, const int* in_sizes, int n_in, void* d_out, int out_size, void* d_ws, size_t ws_size, hipStream_t stream) {
    static int grid_blocks = 0;
    if (grid_blocks == 0) {
        if (n_in != 18 || ws_size < WS_END) { fprintf(stderr, "kernel_launch: expected 18 inputs and >= %zu bytes of workspace (got %d, %zu)\n", (size_t)WS_END, n_in, ws_size); grid_blocks = -1; return; }
        int dev = 0, cus = 0, per_cu = 0;
        hipGetDevice(&dev);
        hipDeviceGetAttribute(&cus, hipDeviceAttributeMultiprocessorCount, dev);
        if (hipFuncSetAttribute((const void*)fwd_megakernel, hipFuncAttributeMaxDynamicSharedMemorySize, LDS_BYTES) != hipSuccess) { fprintf(stderr, "kernel_launch: hipFuncSetAttribute failed\n"); grid_blocks = -1; return; }
        if (hipOccupancyMaxActiveBlocksPerMultiprocessor(&per_cu, (const void*)fwd_megakernel, NWAVES * 64, LDS_BYTES) != hipSuccess || per_cu < 1) { fprintf(stderr, "kernel_launch: occupancy query reports %d blocks per CU\n", per_cu); per_cu = 1; (void)hipGetLastError(); }
        grid_blocks = cus * (per_cu > 1 ? 1 : per_cu);
    }
    if (grid_blocks < 0) return;
    Args a{};
    for (int i = 0; i < 18; ++i) a.in[i] = (const float*)d_in[i];
    a.out = (float*)d_out; a.ws = (unsigned char*)d_ws;
    a.ph_lo = 0; a.ph_hi = 8;
    if (hipMemsetAsync(d_ws, 0, 16384, stream) != hipSuccess) { fprintf(stderr, "kernel_launch: hipMemsetAsync of the barrier words failed\n"); return; }
    void* kargs[] = {&a};
    hipError_t e = hipLaunchCooperativeKernel((const void*)fwd_megakernel, dim3(grid_blocks), dim3(NWAVES * 64), kargs, LDS_BYTES, stream);
    if (e != hipSuccess) fprintf(stderr, "kernel_launch: cooperative launch failed: %s (grid %d)\n", hipGetErrorString(e), grid_blocks);
}
```

```cpp
#include <hip/hip_runtime.h>
#include <hip/hip_cooperative_groups.h>
#include <cstdio>
#include <cstdint>
namespace cg = cooperative_groups;


#define LAS __attribute__((address_space(3)))
typedef unsigned short bf16_t;
typedef short bf16x8 __attribute__((ext_vector_type(8)));
typedef short s16x4 __attribute__((ext_vector_type(4)));
typedef float f32x4 __attribute__((ext_vector_type(4)));
typedef float f32x2 __attribute__((ext_vector_type(2)));
typedef unsigned u32x4 __attribute__((ext_vector_type(4)));
typedef unsigned u32x2 __attribute__((ext_vector_type(2)));

constexpr int DM = 2048, NPROMPT = 8192, NSAMPLE = 1024, MROWS = NPROMPT + NSAMPLE;
constexpr int SEQ = 2048, NBATCH = 4, DECB = 128, DECT = 8;
constexpr int QW = 1024, KVW = 256, GW = 1024, DFF = 5632, INW = 7680;
constexpr float EPS = 1e-6f;
constexpr float LOG2E = 1.4426950408889634f;
constexpr float QSCALE = 0.125f * LOG2E;
constexpr float NEGBIG = -1e30f;

constexpr size_t O_Y = 0;
constexpr size_t O_PK = (size_t)MROWS * DM;
constexpr size_t O_PV = O_PK + 4 * 128 * 256;
constexpr size_t O_SK = O_PV + 4 * 128 * 256;
constexpr size_t O_SV = O_SK + (size_t)DECB * 128 * 256;
constexpr size_t O_SG = O_SV + (size_t)DECB * 128 * 256;

constexpr size_t MiB = 1u << 20;
constexpr size_t WS_WIN = 1 * MiB, WS_WPA = 31 * MiB, WS_WPB = 35 * MiB, WS_WO = 39 * MiB, WS_WGU = 47 * MiB, WS_WD = 91 * MiB;
constexpr size_t WS_STG = 113 * MiB, WS_SS2 = 115 * MiB, WS_SS3 = 117 * MiB;
constexpr size_t WS_A = 119 * MiB;
constexpr size_t WS_PART = WS_A;
constexpr size_t WS_H = WS_A, WS_XG = WS_A;
constexpr size_t WS_ATT = 218 * MiB, WS_GM = 236 * MiB;
constexpr size_t WS_B = 155 * MiB;
constexpr size_t WS_Q = WS_B, WS_K = WS_B + 18 * MiB, WS_V = WS_K + 4608 * 1024, WS_U = WS_B + 27 * MiB, WS_GV = WS_B + 45 * MiB, WS_MIX = WS_B;
constexpr size_t WS_ACT = WS_B;
constexpr size_t WS_END = 254 * MiB;

constexpr int NWAVES = 8;
constexpr int LDS_BYTES = 147456;
constexpr int XB_LDS_OFF = 139264;

typedef __bf16 bf16x2_t __attribute__((ext_vector_type(2)));
__device__ __forceinline__ unsigned cvt_pk_bf16(float lo, float hi) { const f32x2 v = {lo, hi}; const bf16x2_t b = __builtin_convertvector(v, bf16x2_t); return __builtin_bit_cast(unsigned, b); }
__device__ __forceinline__ float bf_lo(unsigned w) { return __uint_as_float(w << 16); }
__device__ __forceinline__ float bf_hi(unsigned w) { return __uint_as_float(w & 0xffff0000u); }
__device__ __forceinline__ float bf1(bf16_t b) { return __uint_as_float((unsigned)b << 16); }
__device__ __forceinline__ float fast_rcp(float x) { return __builtin_amdgcn_rcpf(x); }
__device__ __forceinline__ float fast_exp2(float x) { return __builtin_amdgcn_exp2f(x); }
__device__ __forceinline__ float sigmoid_f(float x) { return fast_rcp(1.0f + fast_exp2(-LOG2E * x)); }
__device__ __forceinline__ float gelu_tanh_f(float x) { const float t = x + 0.044715f * x * x * x; return x * fast_rcp(1.0f + fast_exp2(-2.3022081983f * t)); }
__device__ __forceinline__ float wave_sum(float v) {
#pragma unroll
    for (int o = 1; o < 64; o <<= 1) v += __shfl_xor(v, o);
    return v;
}

namespace pg8 {
constexpr int BM = 256, BK = 64, HALF = 128, HTB = HALF * BK * 2, STAGE_BYTES = 8 * HTB, NXCD = 8, WGM = 8;
__host__ __device__ __forceinline__ int lds_byte(int r, int c) { const int st = (r >> 4) * 2 + (c >> 5), rr = r & 15, cc = c & 31, ob = rr * 64 + cc * 2; return st * 1024 + (ob ^ (((ob >> 9) & 1) << 5)); }
__host__ __device__ __forceinline__ void stage_rc(int b, int& R, int& C) { const int st = b / 1024, sb = b % 1024, swz = sb ^ (((sb >> 9) & 1) << 5); R = (st >> 1) * 16 + swz / 64; C = (st & 1) * 32 + (swz % 64) / 2; }
__host__ __device__ __forceinline__ int perm32(int rho) { const int n = rho >> 4, i = rho & 15; return 8 * (i >> 2) + 4 * n + (i & 3); }

struct Unit { int pm, pn, sel, kofs, nkt; };
struct Gemm { const bf16_t* A0; const bf16_t* B0; const bf16_t* A1; const bf16_t* B1; int M, N, K; };

struct StaticOrder {
    int nM, nN, nwg, G, c;
    __device__ void init(int M, int N, int K, int G_, int c_) { nM = M / BM; nN = N / BM; nwg = nM * nN; G = G_; c = c_; nkt = K / BK; }
    int nkt;
    __device__ void tile(int wgid, Unit& u) const {
        const int nig = WGM * nN, gid = wgid / nig, fm = gid * WGM, gsz = (nM - fm) < WGM ? (nM - fm) : WGM;
        u.pm = fm + ((wgid % nig) % gsz); u.pn = (wgid % nig) / gsz; u.sel = 0; u.kofs = 0; u.nkt = nkt;
    }
    __device__ bool next(int i, Unit& u) const {
        const long L = (long)i * G + c; if (L >= nwg) return false;
        int wgid = (int)L; { const int q = nwg / NXCD, r = nwg % NXCD, xcd = wgid % NXCD, off = wgid / NXCD; wgid = (xcd < r ? xcd * (q + 1) : r * (q + 1) + (xcd - r) * q) + off; }
        tile(wgid, u); return true;
    }
};
struct P1Order {
    StaticOrder a, b; int lo, hi;
    __device__ bool next(int i, Unit& u) const {
        const int r = lo + i; if (r >= hi) return false;
        long L = (long)r * a.G + a.c;
        const StaticOrder& s = (L < a.nwg) ? a : b; if (L >= a.nwg) L -= a.nwg;
        if (L >= s.nwg) return false;
        int wgid = (int)L; { const int q = s.nwg / NXCD, rr = s.nwg % NXCD, xcd = wgid % NXCD, off = wgid / NXCD; wgid = (xcd < rr ? xcd * (q + 1) : rr * (q + 1) + (xcd - rr) * q) + off; }
        s.tile(wgid, u); if (&s == &b) u.pn += 14; return true;
    }
};
struct DualOrder {
    StaticOrder b;
    __device__ bool next(int i, Unit& u) const { if (!b.next(i >> 1, u)) return false; u.sel = i & 1; return true; }
};

struct Ph45Order {
    StaticOrder p4p, p4s, p5p, p5s, p4all, p5all; int sp; bool split;
    __device__ static int swz(const StaticOrder& s, long L) { const int w = (int)L, q = s.nwg / NXCD, r = s.nwg % NXCD, xcd = w % NXCD, off = w / NXCD; return (xcd < r ? xcd * (q + 1) : r * (q + 1) + (xcd - r) * q) + off; }
    __device__ bool next(int i, Unit& u) const {
        if (!split) { if (sp == 0) { const bool ok = p4all.next(i, u); u.sel = 1; return ok; } if (sp == 1) return false; return p5all.next(i, u); }
        const int c = p4p.c;
        if (sp == 0) { if (i) return false; p4p.tile(swz(p4p, c), u); u.sel = 1; return true; }
        if (sp == 1) {
            if (c < 32) { if (i) return false; p4s.tile(swz(p4s, c), u); u.pm += 32; u.sel = 1; return true; }
            if (i > 1) return false; p5p.tile(swz(p5p, (c - 32) + 224 * i), u); return true; }
        const long J = (long)i * 256 + c; if (J >= 1136) return false;
        if (J < 960) p5p.tile(swz(p5p, 448 + J), u); else { p5s.tile(swz(p5s, J - 960), u); u.pm += 32; }
        return true;
    }
};

struct SplitTailOrder {
    StaticOrder p, all; int pass; bool split;
    __device__ bool next(int i, Unit& u) const {
        if (!split) return pass == 0 ? all.next(i, u) : false;
        if (i) return false;
        if (pass == 0) { p.tile(Ph45Order::swz(p, p.c), u); return true; }
        if (p.c >= 128) return false;
        const int tl = (p.c & 7) * 4 + (p.c >> 5), sp = (p.c >> 3) & 3;
        u.pm = 32 + (tl & 3); u.pn = tl >> 2; u.sel = 1 + tl; u.nkt = p.nkt / 4; u.kofs = sp * (p.nkt / 4); return true;
    }
};
template <class Epi, class Sched, bool DUAL = false>
__device__ __forceinline__ void gemm_phase(LAS unsigned char* lds, const Gemm g, const Sched& S, const Epi& E) {
    const int tid = threadIdx.x, wid = __builtin_amdgcn_readfirstlane(tid >> 6), lane = tid & 63, wr = wid >> 2, wc = wid & 3, fr = lane & 15, fq = lane >> 4;
    const int K = g.K;
    unsigned voffA[2], voffB[2];
#pragma unroll
    for (int i = 0; i < 2; ++i) { int R, C; stage_rc(tid * 16 + i * 8192, R, C); const int Rb = (R & ~31) + perm32(R & 31);
        voffA[i] = (unsigned)(R * K + C) * 2u; voffB[i] = (unsigned)(Rb * K + C) * 2u; }
    const size_t kstep = (size_t)(BK * 2);
    const size_t hstep = (size_t)HALF * K * 2;
    const size_t tstep = 2 * hstep;
    const unsigned ldsw = (unsigned)wid * 1024u;
    const int aoff = lds_byte(wr * 64 + fr, fq * 8), boff = lds_byte(wc * 32 + fr, fq * 8);
#define PG8_SA(b, h) (((b) * 2 + (h)) * HTB)
#define PG8_SB(b, h) ((4 + (b) * 2 + (h)) * HTB)
#define PG8_STAGE(bufoff, gbase, voff) do { _Pragma("unroll") for (int _i = 0; _i < 2; ++_i) \
        __builtin_amdgcn_global_load_lds((const unsigned*)((const char*)(gbase) + (voff)[_i]), (LAS unsigned*)(lds + (bufoff) + ldsw + _i * 8192), 16, 0, 0); } while (0)
#define PG8_LDA(dst, b, h) do { _Pragma("unroll") for (int m = 0; m < 4; ++m) _Pragma("unroll") for (int k = 0; k < 2; ++k) dst[m][k] = *(const LAS bf16x8*)(lds + PG8_SA(b, h) + aoff + m * 2048 + k * 1024); } while (0)
#define PG8_LDB(dst, b, h) do { _Pragma("unroll") for (int n = 0; n < 2; ++n) _Pragma("unroll") for (int k = 0; k < 2; ++k) dst[n][k] = *(const LAS bf16x8*)(lds + PG8_SB(b, h) + boff + n * 2048 + k * 1024); } while (0)
#define PG8_MMA(ai, bj, At, Bt) do { __builtin_amdgcn_s_setprio(1); _Pragma("unroll") for (int m = 0; m < 4; ++m) _Pragma("unroll") for (int n = 0; n < 2; ++n) _Pragma("unroll") for (int k = 0; k < 2; ++k) \
        acc[ai][bj][m][n] = __builtin_amdgcn_mfma_f32_16x16x32_bf16(Bt[n][k], At[m][k], acc[ai][bj][m][n], 0, 0, 0); __builtin_amdgcn_s_setprio(0); } while (0)
#define PG8_WAIT_V(n) asm volatile("s_waitcnt vmcnt(" #n ")" ::: "memory")
#define PG8_WAIT_L(n) asm volatile("s_waitcnt lgkmcnt(" #n ")" ::: "memory")
#define PG8_BAR __builtin_amdgcn_s_barrier()
#define PG8_SCHED __builtin_amdgcn_sched_barrier(0)
    Unit cur, nxt; int ui = 0;
    if (!S.next(0, cur)) return;
    f32x4 acc[2][2][4][2];
    E.init_acc(acc, cur, wr, wc, fr, fq);
    bf16x8 At[4][2], B0[2][2], B1[2][2];
    const char* cA = (const char*)((DUAL && cur.sel) ? g.A1 : g.A0) + (size_t)cur.pm * tstep + (size_t)cur.kofs * kstep; const char* cB = (const char*)((DUAL && cur.sel) ? g.B1 : g.B0) + (size_t)cur.pn * tstep + (size_t)cur.kofs * kstep;
    PG8_STAGE(PG8_SB(0, 0), cB, voffB); PG8_STAGE(PG8_SB(0, 1), cB + hstep, voffB); PG8_STAGE(PG8_SA(0, 0), cA, voffA); PG8_STAGE(PG8_SA(0, 1), cA + hstep, voffA);
    if (wr == 1) PG8_BAR;
    PG8_WAIT_V(2); PG8_BAR;
    PG8_STAGE(PG8_SB(1, 0), cB + kstep, voffB); PG8_STAGE(PG8_SA(1, 0), cA + kstep, voffA); PG8_STAGE(PG8_SB(1, 1), cB + hstep + kstep, voffB);
    PG8_WAIT_V(6); PG8_BAR;
    for (;;) {
        const bool has_next = S.next(ui + 1, nxt);
        const char* nA = has_next ? (const char*)((DUAL && nxt.sel) ? g.A1 : g.A0) + (size_t)nxt.pm * tstep + (size_t)nxt.kofs * kstep : cA; const char* nB = has_next ? (const char*)((DUAL && nxt.sel) ? g.B1 : g.B0) + (size_t)nxt.pn * tstep + (size_t)nxt.kofs * kstep : cB;
        const int nt = cur.nkt;
        for (int t = 0; t < nt; t += 2) {
            const bool last = (t == nt - 2);
            const char* a1 = cA + (size_t)(t + 1) * kstep;
            const char* a2 = last ? nA : cA + (size_t)(t + 2) * kstep; const char* b2 = last ? nB : cB + (size_t)(t + 2) * kstep;
            const char* a3 = a2 + kstep; const char* b3 = b2 + kstep;
            PG8_LDB(B0, 0, 0); PG8_LDB(B1, 0, 1); PG8_SCHED; PG8_LDA(At, 0, 0); PG8_STAGE(PG8_SA(1, 1), a1 + hstep, voffA);
            PG8_WAIT_V(8); PG8_WAIT_L(0); PG8_BAR; PG8_MMA(0, 0, At, B0); PG8_MMA(0, 1, At, B1); PG8_BAR; PG8_SCHED;
            PG8_LDA(At, 0, 1); PG8_STAGE(PG8_SB(0, 0), b2, voffB); PG8_STAGE(PG8_SB(0, 1), b2 + hstep, voffB); PG8_STAGE(PG8_SA(0, 0), a2, voffA);
            PG8_WAIT_V(8); PG8_WAIT_L(0); PG8_BAR; PG8_MMA(1, 0, At, B0); PG8_MMA(1, 1, At, B1); PG8_BAR; PG8_SCHED;
            PG8_LDB(B0, 1, 0); PG8_LDB(B1, 1, 1); PG8_SCHED; PG8_LDA(At, 1, 0); PG8_STAGE(PG8_SA(0, 1), a2 + hstep, voffA);
            PG8_WAIT_V(8); PG8_WAIT_L(0); PG8_BAR; PG8_MMA(0, 0, At, B0); PG8_MMA(0, 1, At, B1); PG8_BAR; PG8_SCHED;
            PG8_LDA(At, 1, 1); PG8_STAGE(PG8_SB(1, 0), b3, voffB); PG8_STAGE(PG8_SB(1, 1), b3 + hstep, voffB); PG8_STAGE(PG8_SA(1, 0), a3, voffA);
            PG8_WAIT_V(8); PG8_WAIT_L(0); PG8_BAR; PG8_MMA(1, 0, At, B0); PG8_MMA(1, 1, At, B1); PG8_BAR; PG8_SCHED;
        }
        if (wr == 0) PG8_BAR;
        { int fr_e = fr, fq_e = fq; asm volatile("" : "+v"(fr_e), "+v"(fq_e));
          E(acc, cur, wr, wc, fr_e, fq_e); }
        if (!has_next) break;
        if (!E.keep(cur)) { int fr_i = fr, fq_i = fq; asm volatile("" : "+v"(fr_i), "+v"(fq_i)); E.init_acc(acc, nxt, wr, wc, fr_i, fq_i); }
        cur = nxt; cA = nA; cB = nB; ++ui;
        if (wr == 1) PG8_BAR;
    }
    PG8_WAIT_V(0);
    PG8_BAR;
#undef PG8_SA
#undef PG8_SB
#undef PG8_STAGE
#undef PG8_LDA
#undef PG8_LDB
#undef PG8_MMA
#undef PG8_WAIT_V
#undef PG8_WAIT_L
#undef PG8_BAR
#undef PG8_SCHED
}
}

typedef f32x4 (&AccRef)[2][2][4][2];

__device__ __forceinline__ void acc_zero(AccRef acc) {
#pragma unroll
    for (int a = 0; a < 2; ++a)
#pragma unroll
        for (int b = 0; b < 2; ++b)
#pragma unroll
            for (int m = 0; m < 4; ++m)
#pragma unroll
                for (int n = 0; n < 2; ++n) acc[a][b][m][n] = (f32x4){0.f, 0.f, 0.f, 0.f};
}
__device__ __forceinline__ void acc_load(AccRef acc, const float* base, int rowt, int col0) {
#pragma unroll
    for (int ai = 0; ai < 2; ++ai)
#pragma unroll
        for (int m = 0; m < 4; ++m) { const float* rp = base + (size_t)(rowt + ai * 128 + m * 16) * DM + col0;
#pragma unroll
            for (int bj = 0; bj < 2; ++bj) { acc[ai][bj][m][0] = __builtin_nontemporal_load((const f32x4*)(rp + bj * 128)); acc[ai][bj][m][1] = __builtin_nontemporal_load((const f32x4*)(rp + bj * 128 + 4)); } }
}
template <int ACT>
__device__ __forceinline__ f32x4 act4(f32x4 v) {
    if (ACT == 1) return v * QSCALE;
    if (ACT == 2) return (f32x4){gelu_tanh_f(v[0]), gelu_tanh_f(v[1]), gelu_tanh_f(v[2]), gelu_tanh_f(v[3])};
    if (ACT == 3) return (f32x4){sigmoid_f(v[0]), sigmoid_f(v[1]), sigmoid_f(v[2]), sigmoid_f(v[3])};
    return v;
}
#define EPI_PIN(ai, m) f32x4 aq[2][2] = {{acc[ai][0][m][0], acc[ai][0][m][1]}, {acc[ai][1][m][0], acc[ai][1][m][1]}}; \
    asm volatile("" : "+v"(aq[0][0]), "+v"(aq[0][1]), "+v"(aq[1][0]), "+v"(aq[1][1]) :: "memory")
template <int ACT>
__device__ __forceinline__ void epi_store_bf16(AccRef acc, bf16_t* base, int ld, int rowt, int cw) {
#pragma unroll
    for (int ai = 0; ai < 2; ++ai)
#pragma unroll
        for (int m = 0; m < 4; ++m) { EPI_PIN(ai, m); bf16_t* rowp = base + (size_t)(rowt + ai * 128 + m * 16) * ld + cw;
#pragma unroll
            for (int bj = 0; bj < 2; ++bj) { const f32x4 v0 = act4<ACT>(aq[bj][0]), v1 = act4<ACT>(aq[bj][1]);
                u32x4 w; w.x = cvt_pk_bf16(v0[0], v0[1]); w.y = cvt_pk_bf16(v0[2], v0[3]); w.z = cvt_pk_bf16(v1[0], v1[1]); w.w = cvt_pk_bf16(v1[2], v1[3]);
                *(u32x4*)(rowp + bj * 128) = w; } }
}

struct Epi1 {
    bf16_t *Q, *Kb, *Vb, *U, *GV, *SA, *SB; float* stg; float* out;
    __device__ __forceinline__ void init_acc(AccRef acc, const pg8::Unit&, int, int, int, int) const { acc_zero(acc); }
    __device__ __forceinline__ bool keep(const pg8::Unit&) const { return false; }
    __device__ __forceinline__ void operator()(AccRef acc, const pg8::Unit& u, int wr, int wc, int fr, int fq) const {
        const int pn = u.pn, rowt = u.pm * 256 + wr * 64 + fr, cw = wc * 32 + 8 * fq;
        if (pn < 4) { epi_store_bf16<1>(acc, Q + pn * 256, QW, rowt, cw); }
        else if (pn < 6) {
            bf16_t* kb = (pn == 4) ? Kb : Vb;
            epi_store_bf16<0>(acc, kb, KVW, rowt, cw);
            if (u.pm >= 32) {
                float* ob = out + (pn == 4 ? O_SK : O_SV);
#pragma unroll
                for (int ai = 0; ai < 2; ++ai)
#pragma unroll
                    for (int m = 0; m < 4; ++m) { EPI_PIN(ai, m); const int r = rowt + ai * 128 + m * 16 - NPROMPT; const int sb = r >> 3, t = r & 7;
                        float* rowp = ob + ((size_t)sb * 128 + 120 + t) * 256 + cw;
#pragma unroll
                        for (int bj = 0; bj < 2; ++bj) { *(f32x4*)(rowp + bj * 128) = aq[bj][0]; *(f32x4*)(rowp + bj * 128 + 4) = aq[bj][1]; } }
            } else if ((u.pm & 7) == 7) {
                float* ob = out + (pn == 4 ? O_PK : O_PV);
#pragma unroll
                for (int m = 0; m < 4; ++m) { EPI_PIN(1, m); const int tw = wr * 64 + m * 16 + fr; float* rowp = ob + ((size_t)(u.pm >> 3) * 128 + tw) * 256 + cw;
#pragma unroll
                    for (int bj = 0; bj < 2; ++bj) { *(f32x4*)(rowp + bj * 128) = aq[bj][0]; *(f32x4*)(rowp + bj * 128 + 4) = aq[bj][1]; } }
            }
        }
        else if (pn < 10) { epi_store_bf16<2>(acc, U + (pn - 6) * 256, GW, rowt, cw); }
        else if (pn < 14) {
            bf16_t* base = GV + (pn - 10) * 256;
#pragma unroll
            for (int ai = 0; ai < 2; ++ai)
#pragma unroll
                for (int m = 0; m < 4; ++m) { EPI_PIN(ai, m); const int row = rowt + ai * 128 + m * 16; bf16_t* rowp = base + (size_t)row * GW + cw; float s = 0.f, q = 0.f;
#pragma unroll
                    for (int bj = 0; bj < 2; ++bj) { const f32x4 v0 = act4<2>(aq[bj][0]), v1 = act4<2>(aq[bj][1]);
                        s += (v0[0] + v0[1]) + (v0[2] + v0[3]) + (v1[0] + v1[1]) + (v1[2] + v1[3]);
                        q += (v0[0] * v0[0] + v0[1] * v0[1]) + (v0[2] * v0[2] + v0[3] * v0[3]) + (v1[0] * v1[0] + v1[1] * v1[1]) + (v1[2] * v1[2] + v1[3] * v1[3]);
                        u32x4 w; w.x = cvt_pk_bf16(v0[0], v0[1]); w.y = cvt_pk_bf16(v0[2], v0[3]); w.z = cvt_pk_bf16(v1[0], v1[1]); w.w = cvt_pk_bf16(v1[2], v1[3]);
                        *(u32x4*)(rowp + bj * 128) = w; }
                    s += __shfl_xor(s, 16); s += __shfl_xor(s, 32); q += __shfl_xor(q, 16); q += __shfl_xor(q, 32);
                    if (fq == 0) *(f32x2*)(stg + (size_t)row * 32 + ((pn - 10) * 4 + wc) * 2) = (f32x2){s, q}; }
        }
        else if (pn < 22) { epi_store_bf16<3>(acc, SA + (pn - 14) * 256, DM, rowt, cw); }
        else { epi_store_bf16<3>(acc, SB + (pn - 22) * 256, DM, rowt, cw); }
    }
};

struct Epi3 {
    const bf16_t *SA, *SB; bf16_t *MIXP, *MIXS;
    __device__ __forceinline__ void init_acc(AccRef acc, const pg8::Unit&, int, int, int, int) const { acc_zero(acc); }
    __device__ __forceinline__ bool keep(const pg8::Unit& u) const { return u.sel == 0; }
    __device__ __forceinline__ void operator()(AccRef acc, const pg8::Unit& u, int wr, int wc, int fr, int fq) const {
        const int rowt = u.pm * 256 + wr * 64 + fr, col0 = u.pn * 256 + wc * 32 + 8 * fq;
        bf16_t* MIX = (u.pm < 32) ? MIXP : MIXS;
#pragma unroll
        for (int ai = 0; ai < 2; ++ai) {
            u32x4 bw[4][2], aw[4][2];
#pragma unroll
            for (int m = 0; m < 4; ++m) { const size_t off = (size_t)(rowt + ai * 128 + m * 16) * DM + col0;
#pragma unroll
                for (int bj = 0; bj < 2; ++bj) { bw[m][bj] = *(const u32x4*)(SB + off + bj * 128); if (u.sel == 0) aw[m][bj] = *(const u32x4*)(SA + off + bj * 128); } }
#pragma unroll
            for (int m = 0; m < 4; ++m) { const size_t off = (size_t)(rowt + ai * 128 + m * 16) * DM + col0;
                asm volatile("" : "+v"(acc[ai][0][m][0]), "+v"(acc[ai][0][m][1]), "+v"(acc[ai][1][m][0]), "+v"(acc[ai][1][m][1]));
#pragma unroll
                for (int bj = 0; bj < 2; ++bj) { const u32x4 b4 = bw[m][bj];
                    f32x4 b0 = (f32x4){bf_lo(b4.x), bf_hi(b4.x), bf_lo(b4.y), bf_hi(b4.y)}, b1 = (f32x4){bf_lo(b4.z), bf_hi(b4.z), bf_lo(b4.w), bf_hi(b4.w)};
#pragma unroll
                    for (int j = 0; j < 4; ++j) { b0[j] = fmaxf(b0[j], 1e-20f); b1[j] = fmaxf(b1[j], 1e-20f); }
                    if (u.sel == 0) { const u32x4 a4 = aw[m][bj];
                        const f32x4 a0 = (f32x4){bf_lo(a4.x), bf_hi(a4.x), bf_lo(a4.y), bf_hi(a4.y)}, a1 = (f32x4){bf_lo(a4.z), bf_hi(a4.z), bf_lo(a4.w), bf_hi(a4.w)};
#pragma unroll
                        for (int j = 0; j < 4; ++j) { acc[ai][bj][m][0][j] *= a0[j] * fast_rcp(b0[j]); acc[ai][bj][m][1][j] *= a1[j] * fast_rcp(b1[j]); } }
                    else { const f32x4 v0 = b0 * acc[ai][bj][m][0], v1 = b1 * acc[ai][bj][m][1];
                        u32x4 w; w.x = cvt_pk_bf16(v0[0], v0[1]); w.y = cvt_pk_bf16(v0[2], v0[3]); w.z = cvt_pk_bf16(v1[0], v1[1]); w.w = cvt_pk_bf16(v1[2], v1[3]);
                        *(u32x4*)(MIX + off + bj * 128) = w; } }
                asm volatile("" : "+v"(acc[ai][0][m][0]), "+v"(acc[ai][0][m][1]), "+v"(acc[ai][1][m][0]), "+v"(acc[ai][1][m][1])); }
            asm volatile("" ::: "memory");
        }
    }
};

struct Epi4 {
    const float *xp, *xs, *g2; float* X1; bf16_t* XG; float* ss2;
    __device__ __forceinline__ void init_acc(AccRef acc, const pg8::Unit& u, int wr, int wc, int fr, int fq) const {
        acc_load(acc, (u.pm < 32) ? xp : (xs - (size_t)NPROMPT * DM), u.pm * 256 + wr * 64 + fr, u.pn * 256 + wc * 32 + 8 * fq); }
    __device__ __forceinline__ bool keep(const pg8::Unit&) const { return false; }
    __device__ __forceinline__ void operator()(AccRef acc, const pg8::Unit& u, int wr, int wc, int fr, int fq) const {
        const int rowt = u.pm * 256 + wr * 64 + fr, col0 = u.pn * 256 + wc * 32 + 8 * fq;
#pragma unroll
        for (int ai = 0; ai < 2; ++ai)
#pragma unroll
            for (int m = 0; m < 4; ++m) { EPI_PIN(ai, m); const int row = rowt + ai * 128 + m * 16; const size_t off = (size_t)row * DM + col0; float q = 0.f;
                f32x4 gv[2][2];
#pragma unroll
                for (int bj = 0; bj < 2; ++bj) { gv[bj][0] = *(const f32x4*)(g2 + col0 + bj * 128); gv[bj][1] = *(const f32x4*)(g2 + col0 + bj * 128 + 4); }
#pragma unroll
                for (int bj = 0; bj < 2; ++bj) { const f32x4 v0 = aq[bj][0], v1 = aq[bj][1];
                    *(f32x4*)(X1 + off + bj * 128) = v0; *(f32x4*)(X1 + off + bj * 128 + 4) = v1;
                    q += (v0[0] * v0[0] + v0[1] * v0[1]) + (v0[2] * v0[2] + v0[3] * v0[3]) + (v1[0] * v1[0] + v1[1] * v1[1]) + (v1[2] * v1[2] + v1[3] * v1[3]);
                    const f32x4 h0 = v0 * gv[bj][0], h1 = v1 * gv[bj][1];
                    u32x4 w; w.x = cvt_pk_bf16(h0[0], h0[1]); w.y = cvt_pk_bf16(h0[2], h0[3]); w.z = cvt_pk_bf16(h1[0], h1[1]); w.w = cvt_pk_bf16(h1[2], h1[3]);
                    *(u32x4*)(XG + off + bj * 128) = w; }
                q += __shfl_xor(q, 16); q += __shfl_xor(q, 32);
                if (fq == 0) ss2[(size_t)row * 32 + u.pn * 4 + wc] = q; }
    }
};

struct Epi5 {
    const float* ss2; bf16_t* ACT;
    __device__ __forceinline__ void init_acc(AccRef acc, const pg8::Unit&, int, int, int, int) const { acc_zero(acc); }
    __device__ __forceinline__ bool keep(const pg8::Unit&) const { return false; }
    __device__ __forceinline__ void operator()(AccRef acc, const pg8::Unit& u, int wr, int wc, int fr, int fq) const {
        const int rowt = u.pm * 256 + wr * 64 + fr, col0 = u.pn * 128 + wc * 32 + 8 * fq;
        float rs[8]; f32x4 pp[8][2];
#pragma unroll
        for (int r = 0; r < 8; ++r) { const float* sp = ss2 + (size_t)(rowt + (r >> 2) * 128 + (r & 3) * 16) * 32 + fq * 8; pp[r][0] = *(const f32x4*)sp; pp[r][1] = *(const f32x4*)(sp + 4); }
#pragma unroll
        for (int r = 0; r < 8; ++r) { float sm = (pp[r][0][0] + pp[r][0][1]) + (pp[r][0][2] + pp[r][0][3]) + (pp[r][1][0] + pp[r][1][1]) + (pp[r][1][2] + pp[r][1][3]);
            sm += __shfl_xor(sm, 16); sm += __shfl_xor(sm, 32); rs[r] = __builtin_amdgcn_rsqf(sm * (1.0f / DM) + EPS); }
        asm volatile("" ::: "memory");
#pragma unroll
        for (int ai = 0; ai < 2; ++ai)
#pragma unroll
            for (int m = 0; m < 4; ++m) { EPI_PIN(ai, m); const int row = rowt + ai * 128 + m * 16; const float rstd = rs[ai * 4 + m];
                f32x4 o[2];
#pragma unroll
                for (int n = 0; n < 2; ++n) { const f32x4 gt = aq[0][n] * rstd, up = aq[1][n] * rstd;
#pragma unroll
                    for (int j = 0; j < 4; ++j) o[n][j] = gt[j] * sigmoid_f(gt[j]) * up[j]; }
                u32x4 w; w.x = cvt_pk_bf16(o[0][0], o[0][1]); w.y = cvt_pk_bf16(o[0][2], o[0][3]); w.z = cvt_pk_bf16(o[1][0], o[1][1]); w.w = cvt_pk_bf16(o[1][2], o[1][3]);
                *(u32x4*)(ACT + (size_t)row * DFF + col0) = w; }
    }
};

struct Epi45 {
    Epi4 e4; Epi5 e5;
    __device__ __forceinline__ void init_acc(AccRef acc, const pg8::Unit& u, int wr, int wc, int fr, int fq) const { if (u.sel) e4.init_acc(acc, u, wr, wc, fr, fq); else acc_zero(acc); }
    __device__ __forceinline__ bool keep(const pg8::Unit&) const { return false; }
    __device__ __forceinline__ void operator()(AccRef acc, const pg8::Unit& u, int wr, int wc, int fr, int fq) const { if (u.sel) e4(acc, u, wr, wc, fr, fq); else e5(acc, u, wr, wc, fr, fq); }
};

struct Epi6 {
    float* Y; float* part;
    __device__ __forceinline__ void init_acc(AccRef acc, const pg8::Unit& u, int wr, int wc, int fr, int fq) const {
        if (u.sel == 0) acc_load(acc, Y, u.pm * 256 + wr * 64 + fr, u.pn * 256 + wc * 32 + 8 * fq); else acc_zero(acc); }
    __device__ __forceinline__ bool keep(const pg8::Unit&) const { return false; }
    __device__ __forceinline__ void operator()(AccRef acc, const pg8::Unit& u, int wr, int wc, int fr, int fq) const {
        const int rt = wr * 64 + fr, cw = wc * 32 + 8 * fq;
        float* pb = (u.sel == 0) ? Y + (size_t)u.pm * 256 * DM + u.pn * 256 : part + ((size_t)(u.kofs / u.nkt) * 32 + (u.sel - 1)) * 65536;
        const int ld = (u.sel == 0) ? DM : 256;
#pragma unroll
        for (int ai = 0; ai < 2; ++ai)
#pragma unroll
            for (int m = 0; m < 4; ++m) { EPI_PIN(ai, m); float* rowp = pb + (size_t)(rt + ai * 128 + m * 16) * ld + cw;
#pragma unroll
                for (int bj = 0; bj < 2; ++bj) { *(f32x4*)(rowp + bj * 128) = aq[bj][0]; *(f32x4*)(rowp + bj * 128 + 4) = aq[bj][1]; } }
    }
};

__device__ __forceinline__ void p0_transpose_item(const float* W, int K, int N, bf16_t* WT, int drow0, int k0, int n0, LAS float* scr, int lane) {
    const int kq = lane >> 4, n4 = (lane & 15) * 4;
    f32x4 v[16];
#pragma unroll
    for (int i = 0; i < 16; ++i) v[i] = __builtin_nontemporal_load((const f32x4*)(W + (size_t)(k0 + 4 * i + kq) * N + n0 + n4));
#pragma unroll
    for (int i = 0; i < 16; ++i) { LAS float* p = scr + (4 * i + kq) * 65 + n4; p[0] = v[i][0]; p[1] = v[i][1]; p[2] = v[i][2]; p[3] = v[i][3]; }
    asm volatile("s_waitcnt lgkmcnt(0)" ::: "memory");
    const int c = lane & 7;
#pragma unroll
    for (int j = 0; j < 8; ++j) { const int n = (lane >> 3) + 8 * j; const LAS float* s = scr + (8 * c) * 65 + n;
        u32x4 o; o.x = cvt_pk_bf16(s[0 * 65], s[1 * 65]); o.y = cvt_pk_bf16(s[2 * 65], s[3 * 65]); o.z = cvt_pk_bf16(s[4 * 65], s[5 * 65]); o.w = cvt_pk_bf16(s[6 * 65], s[7 * 65]);
        *(u32x4*)(WT + (size_t)(drow0 + n) * K + k0 + 8 * c) = o; }
    asm volatile("s_waitcnt lgkmcnt(0)" ::: "memory");
}

constexpr int KS_STRIDE = 144;
constexpr int VT_STRIDE = 528;
constexpr int ATT_VT_OFF = 256 * KS_STRIDE;

template <int NKT>
__device__ __forceinline__ void attn_tile(LAS const unsigned char* Ks, LAS const unsigned char* VT, bf16x8 q0, bf16x8 q1, int qi, int kt0, bool mask_prev, float sink2, bf16_t* optr, int lane) {
    const int l15 = lane & 15, quad = lane >> 4;
    bf16x8 qf[2]; qf[0] = q0; qf[1] = q1;
    LAS const unsigned char* Kw = Ks + kt0 * 16 * KS_STRIDE; LAS const unsigned char* Vw = VT + kt0 * 32;
    f32x4 s[NKT];
#pragma unroll
    for (int nt = 0; nt < NKT; ++nt) { s[nt] = (f32x4){0.f, 0.f, 0.f, 0.f}; if ((nt & 1) == 0) asm volatile("" ::: "memory");
#pragma unroll
        for (int ks = 0; ks < 2; ++ks) { const bf16x8 a = *(LAS const bf16x8*)(Kw + (nt * 16 + l15) * KS_STRIDE + ks * 64 + quad * 16);
            s[nt] = __builtin_amdgcn_mfma_f32_16x16x32_bf16(a, qf[ks], s[nt], 0, 0, 0); } }
    float mx = NEGBIG;
#pragma unroll
    for (int nt = 0; nt < NKT; ++nt) {
        if (mask_prev || nt < 2 || nt >= 8) {
#pragma unroll
            for (int j = 0; j < 4; ++j) { const int kidx = (kt0 + nt) * 16 + quad * 4 + j, diff = 128 + qi - kidx;
                const bool valid = (diff >= 0) && (diff <= 128) && !(mask_prev && kidx < 128);
                s[nt][j] = valid ? s[nt][j] : NEGBIG; } }
#pragma unroll
        for (int j = 0; j < 4; ++j) mx = fmaxf(mx, s[nt][j]); }
    mx = fmaxf(mx, __shfl_xor(mx, 16)); mx = fmaxf(mx, __shfl_xor(mx, 32)); mx = fmaxf(mx, sink2);
    float sum = 0.f;
#pragma unroll
    for (int nt = 0; nt < NKT; ++nt)
#pragma unroll
        for (int j = 0; j < 4; ++j) { const float p = fast_exp2(s[nt][j] - mx); s[nt][j] = p; sum += p; }
    sum += __shfl_xor(sum, 16); sum += __shfl_xor(sum, 32);
    const float inv = 1.0f / (sum + fast_exp2(sink2 - mx));
    f32x4 o[4];
#pragma unroll
    for (int mt = 0; mt < 4; ++mt) o[mt] = (f32x4){0.f, 0.f, 0.f, 0.f};
#pragma unroll
    for (int i = 0; i < NKT / 2; ++i) {
        asm volatile("" ::: "memory");
        u32x4 pw; pw.x = cvt_pk_bf16(s[2 * i][0], s[2 * i][1]); pw.y = cvt_pk_bf16(s[2 * i][2], s[2 * i][3]); pw.z = cvt_pk_bf16(s[2 * i + 1][0], s[2 * i + 1][1]); pw.w = cvt_pk_bf16(s[2 * i + 1][2], s[2 * i + 1][3]);
        const bf16x8 pb = __builtin_bit_cast(bf16x8, pw);
#pragma unroll
        for (int mt = 0; mt < 4; ++mt) { LAS const unsigned char* vp = Vw + (mt * 16 + l15) * VT_STRIDE + (32 * i + quad * 4) * 2;
            const s16x4 lo = *(LAS const s16x4*)vp, hi = *(LAS const s16x4*)(vp + 32);
            const bf16x8 a = (bf16x8){lo[0], lo[1], lo[2], lo[3], hi[0], hi[1], hi[2], hi[3]};
            o[mt] = __builtin_amdgcn_mfma_f32_16x16x32_bf16(a, pb, o[mt], 0, 0, 0); }
    }
#pragma unroll
    for (int mt = 0; mt < 4; ++mt) { const f32x4 v = o[mt] * inv; u32x2 w; w.x = cvt_pk_bf16(v[0], v[1]); w.y = cvt_pk_bf16(v[2], v[3]);
        *(u32x2*)(optr + mt * 16 + quad * 4) = w; }
}

#define XB_TMO      128
#define XB_XCNT(j)  (256  + 64 * (j))
#define XB_XSUB(j)  (1280 + 64 * (j))
#define XB_XGEN(j)  (2304 + 64 * (j))
#define XB_TOP      3328
#define XB_TOPGEN   3392
#define XCD_BAR_WORDS 3456
#define XB_SPIN_CAP (1u << 18)
__device__ __forceinline__ unsigned xb_ld(unsigned* p)              { return __hip_atomic_load(p, __ATOMIC_RELAXED, __HIP_MEMORY_SCOPE_AGENT); }
__device__ __forceinline__ unsigned xb_add(unsigned* p, unsigned v) { return __hip_atomic_fetch_add(p, v, __ATOMIC_RELAXED, __HIP_MEMORY_SCOPE_AGENT); }
__device__ __forceinline__ unsigned xb_xcc_id() { return (unsigned)__builtin_amdgcn_s_getreg((3 << 11) | 20) & 0xFu; }
#define XB_SPIN(cond, bar) do { unsigned _sp = 0; while (cond) { __builtin_amdgcn_s_sleep(1); \
    if ((++_sp & 255u) == 0u) { if (xb_ld(&(bar)[XB_TMO])) break; if (_sp > XB_SPIN_CAP) { atomicAdd(&(bar)[XB_TMO], 1u); break; } } } } while (0)
struct XcdBarrier { unsigned* bar; unsigned x; volatile LAS unsigned* st; };
__device__ __forceinline__ XcdBarrier xcd_barrier_post(unsigned* bar, volatile LAS unsigned* st) {
    XcdBarrier b; b.bar = bar; b.x = xb_xcc_id(); b.st = st;
    if (threadIdx.x == 0) (void)xb_add(&bar[XB_XCNT(b.x)], 1u);
    return b;
}
__device__ __forceinline__ void xcd_barrier_complete(unsigned* bar, unsigned x, unsigned& nloc, unsigned& nx) {
    const unsigned G = gridDim.x * gridDim.y * gridDim.z;
    unsigned sum, cnt, mine, sp = 0u;
    for (;;) {
        sum = 0u; cnt = 0u; mine = 0u;
#pragma unroll
        for (unsigned j = 0; j < 16; ++j) { const unsigned c = xb_ld(&bar[XB_XCNT(j)]); sum += c; cnt += (c > 0u) ? 1u : 0u; mine = (j == x) ? c : mine; }
        if (sum == G) break;
        __builtin_amdgcn_s_sleep(1);
        if ((++sp & 255u) == 0u) { if (xb_ld(&bar[XB_TMO])) break; if (sp > XB_SPIN_CAP) { atomicAdd(&bar[XB_TMO], 1u); break; } }
    }
    nloc = mine > 0u ? mine : 1u; nx = cnt > 0u ? cnt : 1u;
}
__device__ __forceinline__ void xcd_barrier(const XcdBarrier& b) {
    asm volatile("s_waitcnt vmcnt(0)" ::: "memory");
    __syncthreads();
    if (threadIdx.x == 0) {
        unsigned* bar = b.bar;
        __builtin_amdgcn_s_waitcnt(0);
        unsigned nloc = b.st[0], nx = b.st[1];
        if (nloc == 0u) { xcd_barrier_complete(bar, b.x, nloc, nx); b.st[0] = nloc; b.st[1] = nx; }
        const unsigned old = xb_add(&bar[XB_XSUB(b.x)], 1u);
        const unsigned gen = old / nloc;
        if (old + 1u == (gen + 1u) * nloc) {
            __builtin_amdgcn_fence(__ATOMIC_RELEASE, "agent");
            asm volatile("s_waitcnt vmcnt(0)" ::: "memory");
            const unsigned og = xb_add(&bar[XB_TOP], 1u);
            const unsigned tg = og / nx;
            if (og + 1u == (tg + 1u) * nx) xb_add(&bar[XB_TOPGEN], 1u);
            else XB_SPIN(xb_ld(&bar[XB_TOPGEN]) == tg, bar);
            __builtin_amdgcn_fence(__ATOMIC_ACQUIRE, "agent");
            xb_add(&bar[XB_XGEN(b.x)], 1u);
            asm volatile("s_waitcnt vmcnt(0)" ::: "memory");
        } else {
            XB_SPIN(xb_ld(&bar[XB_XGEN(b.x)]) == gen, bar);
            __builtin_amdgcn_fence(__ATOMIC_ACQUIRE, "agent");
            asm volatile("s_waitcnt vmcnt(0)" ::: "memory");
        }
    }
    __syncthreads();
}

struct Args { const float* in[18]; float* out; unsigned char* ws; int ph_lo, ph_hi; };

__global__ void __launch_bounds__(NWAVES * 64, 2) fwd_megakernel(Args args) {
    extern __shared__ __attribute__((aligned(16))) unsigned char lds_raw[];
    LAS unsigned char* lds = (LAS unsigned char*)lds_raw;
    cg::grid_group grid = cg::this_grid();
    const int tid = threadIdx.x, lane = tid & 63, wave = __builtin_amdgcn_readfirstlane(tid >> 6);
    const int G = gridDim.x, bx = blockIdx.x;
    unsigned char* ws = args.ws; float* out = args.out;
    const float *x_prompt = args.in[0], *x_sample = args.in[1], *cache_k = args.in[2], *cache_v = args.in[3], *norm1_g = args.in[4], *w_in = args.in[5], *gmlp_g = args.in[6],
                *w_s = args.in[7], *b_s = args.in[8], *sinks = args.in[9], *w_pa = args.in[10], *w_pb = args.in[11], *w_o = args.in[12], *norm2_g = args.in[13],
                *w_ffg = args.in[14], *w_ffu = args.in[15], *w_ffd = args.in[16], *final_g = args.in[17];
    bf16_t *WinT = (bf16_t*)(ws + WS_WIN), *WpaT = (bf16_t*)(ws + WS_WPA), *WpbT = (bf16_t*)(ws + WS_WPB), *WoT = (bf16_t*)(ws + WS_WO), *WguT = (bf16_t*)(ws + WS_WGU), *WdT = (bf16_t*)(ws + WS_WD);
    float *STG = (float*)(ws + WS_STG), *SS2 = (float*)(ws + WS_SS2), *SS3 = (float*)(ws + WS_SS3);
    bf16_t *Hb = (bf16_t*)(ws + WS_H), *ATT = (bf16_t*)(ws + WS_ATT), *GM = (bf16_t*)(ws + WS_GM), *XG = (bf16_t*)(ws + WS_XG);
    bf16_t *Qb = (bf16_t*)(ws + WS_Q), *Kb = (bf16_t*)(ws + WS_K), *Vb = (bf16_t*)(ws + WS_V), *Ub = (bf16_t*)(ws + WS_U), *GVb = (bf16_t*)(ws + WS_GV), *MIX = (bf16_t*)(ws + WS_MIX);
    bf16_t* MIXS = (bf16_t*)(ws + WS_WIN) - (size_t)NPROMPT * DM;
    bf16_t *SAb = (bf16_t*)(out + O_Y), *SBb = SAb + (size_t)MROWS * DM, *ACT = (bf16_t*)(ws + WS_ACT);

    const int lo = args.ph_lo, hi = args.ph_hi;
#ifndef PHASE_MASK
#define PHASE_MASK 255
#endif
#define IN(k) (((PHASE_MASK >> (k)) & 1) && lo <= (k) && (k) < hi)
#define SEAM(k) do { if (IN(k) && IN((k) + 1)) xcd_barrier(xbar); } while (0)
    volatile LAS unsigned* xb_st = (volatile LAS unsigned*)(lds + XB_LDS_OFF);
    if (tid < 2) xb_st[tid] = 0u;
    __syncthreads();
    const XcdBarrier xbar = xcd_barrier_post((unsigned*)ws, xb_st);
    if (hi > 1000) grid.sync();
    const int gw = bx * NWAVES + wave, NGW = G * NWAVES;

    if (IN(0)) {
        LAS float* scr = (LAS float*)(lds + wave * 16640);
        constexpr int I_IN = 32 * 120;
        for (int it = gw; it < I_IN; it += NGW) { const int kb = it / 120, nb = it % 120; p0_transpose_item(w_in, DM, INW, WinT, 64 * nb, 64 * kb, 64 * nb, scr, lane); }
        for (int m = gw; m < MROWS; m += NGW) {
            const float* xr = (m < NPROMPT) ? x_prompt + (size_t)m * DM : x_sample + (size_t)(m - NPROMPT) * DM;
            f32x4 v[8]; float ss = 0.f;
#pragma unroll
            for (int j = 0; j < 8; ++j) { v[j] = __builtin_nontemporal_load((const f32x4*)(xr + (j * 64 + lane) * 4)); ss += (v[j][0] * v[j][0] + v[j][1] * v[j][1]) + (v[j][2] * v[j][2] + v[j][3] * v[j][3]); }
            const float rstd = __builtin_amdgcn_rsqf(wave_sum(ss) * (1.0f / DM) + EPS);
#pragma unroll
            for (int j = 0; j < 8; ++j) { const f32x4 gg = *(const f32x4*)(norm1_g + (j * 64 + lane) * 4); const f32x4 h = v[j] * rstd * gg;
                u32x2 w; w.x = cvt_pk_bf16(h[0], h[1]); w.y = cvt_pk_bf16(h[2], h[3]); *(u32x2*)(Hb + (size_t)m * DM + (j * 64 + lane) * 4) = w; }
        }
    }
    SEAM(0);

    const bool p1_split = (G == 256);
    const int p1_full = p1_split ? 4 : (1 << 20), p1_tail = p1_split ? 56 : 0;
    if (IN(1)) {
        pg8::Gemm g{Hb, WinT, Hb, WinT, MROWS, INW, DM}; pg8::P1Order S; S.a.init(MROWS, 14 * 256, DM, G, bx); S.b.init(MROWS, 16 * 256, DM, G, bx); S.lo = 0; S.hi = p1_full;
        Epi1 E{Qb, Kb, Vb, Ub, GVb, SAb, SBb, STG, out};
        pg8::gemm_phase<Epi1, pg8::P1Order>(lds, g, S, E);
    }
    SEAM(1);

    if (IN(2)) {
        int nitems, rank = bx - p1_tail; const bool tailwg = p1_split && bx < p1_tail;
        if (!p1_split) nitems = (1408 - bx + G - 1) / G;
        else if (tailwg) { nitems = (1408 - 1224 - bx + p1_tail - 1) / p1_tail;
            pg8::Gemm g{Hb, WinT, Hb, WinT, MROWS, INW, DM}; pg8::P1Order S; S.a.init(MROWS, 14 * 256, DM, G, bx); S.b.init(MROWS, 16 * 256, DM, G, bx); S.lo = p1_full; S.hi = p1_full + 1;
            Epi1 E{Qb, Kb, Vb, Ub, GVb, SAb, SBb, STG, out};
            pg8::gemm_phase<Epi1, pg8::P1Order>(lds, g, S, E); }
        else nitems = (rank < 56) ? 4 : 8;
        int ws_g = -1;
        for (int k = 0; k < nitems; ++k) {
            int it;
            if (!p1_split) it = bx + k * G;
            else if (tailwg) it = 1224 + bx + k * p1_tail;
            else if (rank < 56) it = (k < 2) ? rank + 200 * k : 256 + rank + 56 * (k - 2);
            else { const int r2 = rank - 56;
                if (k == 0) it = rank;
                else if (k < 4) { it = 256 + 112 + r2 + 144 * (k - 1); if (it >= 768) it = -1; }
                else { it = 768 + r2 + 144 * (k - 4); if (it >= 1224) it = -1; } }
            if (it < 0) continue;
            if (it < 256) {
                const int b = it >> 6, n = (it >> 2) & 15, h = it & 3; ws_g = -1;
                LAS unsigned char* Ks = lds; LAS unsigned char* VT = lds + ATT_VT_OFF;
                const int r = wave >> 1, head = h * 4 + r; const float sink2 = sinks[head] * LOG2E;
                const bf16_t* qbase = Qb + (size_t)(b * SEQ + n * 128 + (wave & 1) * 64 + (lane & 15)) * QW + head * 64 + (lane >> 4) * 8;
                bf16x8 qc0 = *(const bf16x8*)qbase, qc1 = *(const bf16x8*)(qbase + 32);
#pragma unroll
                for (int p = 0; p < 4; ++p) { const int key = p * 64 + (tid >> 3), chunk = tid & 7, pos = (n - 1) * 128 + key;
                    u32x4 v = (u32x4){0u, 0u, 0u, 0u}; if (pos >= 0) v = *(const u32x4*)(Kb + (size_t)(b * SEQ + pos) * KVW + h * 64 + chunk * 8);
                    *(LAS u32x4*)(Ks + key * KS_STRIDE + chunk * 16) = v; }
#pragma unroll
                for (int p = 0; p < 4; ++p) { const int idx = p * 512 + tid, key = idx & 255, chunk = idx >> 8, pos = (n - 1) * 128 + key;
                    u32x4 v = (u32x4){0u, 0u, 0u, 0u}; if (pos >= 0) v = *(const u32x4*)(Vb + (size_t)(b * SEQ + pos) * KVW + h * 64 + chunk * 8);
                    LAS unsigned short* vt = (LAS unsigned short*)(VT + (chunk * 8) * VT_STRIDE + key * 2);
                    vt[0 * (VT_STRIDE / 2)] = (unsigned short)(v.x & 0xffff); vt[1 * (VT_STRIDE / 2)] = (unsigned short)(v.x >> 16);
                    vt[2 * (VT_STRIDE / 2)] = (unsigned short)(v.y & 0xffff); vt[3 * (VT_STRIDE / 2)] = (unsigned short)(v.y >> 16);
                    vt[4 * (VT_STRIDE / 2)] = (unsigned short)(v.z & 0xffff); vt[5 * (VT_STRIDE / 2)] = (unsigned short)(v.z >> 16);
                    vt[6 * (VT_STRIDE / 2)] = (unsigned short)(v.w & 0xffff); vt[7 * (VT_STRIDE / 2)] = (unsigned short)(v.w >> 16); }
                __syncthreads();
#pragma unroll 1
                for (int mt = 0; mt < 4; ++mt) { const int qt = (wave & 1) * 4 + mt, qi = qt * 16 + (lane & 15); const size_t qoff = (size_t)(b * SEQ + n * 128 + qi) * QW + head * 64;
                    const bf16_t* qn = qbase + (size_t)(mt < 3 ? mt + 1 : 3) * 16 * QW; const bf16x8 qn0 = *(const bf16x8*)qn, qn1 = *(const bf16x8*)(qn + 32);
                    attn_tile<10>(Ks, VT, qc0, qc1, qi, qt < 6 ? qt : 6, n == 0, sink2, ATT + qoff, lane);
                    qc0 = qn0; qc1 = qn1; }
                asm volatile("s_waitcnt lgkmcnt(0)\n\ts_barrier" ::: "memory");
            } else if (it < 768) {
                const int id = it - 256, g = id & 7, c = (id >> 3) & 15, b = id >> 7; const int R0 = b * SEQ + c * 128;
                LAS unsigned char* wsL = lds; LAS unsigned char* vnT = lds + 34816; LAS float* stat = (LAS float*)(lds + 69632);
                u32x4 gvv[4];
#pragma unroll
                for (int p = 0; p < 4; ++p) { const int idx = p * 512 + tid, s_ = idx & 127, dc = idx >> 7; gvv[p] = *(const u32x4*)(GVb + (size_t)(R0 + s_) * GW + g * 128 + dc * 8); }
                if (tid < 128) { const float* sp = STG + (size_t)(R0 + tid) * 32; float s = 0.f, q = 0.f;
#pragma unroll
                    for (int j = 0; j < 8; ++j) { const f32x4 v = *(const f32x4*)(sp + 4 * j); s += v[0] + v[2]; q += v[1] + v[3]; }
                    const float mean = s * (1.0f / GW), var = fmaxf(q * (1.0f / GW) - mean * mean, 0.f);
                    stat[2 * tid] = mean; stat[2 * tid + 1] = __builtin_amdgcn_rsqf(var + EPS); }
                if (ws_g != g) { ws_g = g;
#pragma unroll
                for (int p = 0; p < 8; ++p) { const int idx = p * 512 + tid, t = idx >> 5, s4 = (idx & 31) * 4; const f32x4 w = *(const f32x4*)(w_s + ((size_t)g * 128 + t) * 128 + s4);
                    u32x2 o; o.x = cvt_pk_bf16(s4 + 0 <= t ? w[0] : 0.f, s4 + 1 <= t ? w[1] : 0.f); o.y = cvt_pk_bf16(s4 + 2 <= t ? w[2] : 0.f, s4 + 3 <= t ? w[3] : 0.f);
                    *(LAS u32x2*)(wsL + t * 272 + s4 * 2) = o; } }
                __syncthreads();
#pragma unroll
                for (int p = 0; p < 4; ++p) { const int idx = p * 512 + tid, s = idx & 127, dc = idx >> 7; const u32x4 v = gvv[p];
                    const float mean = stat[2 * s], rstd = stat[2 * s + 1]; const f32x4 ga = *(const f32x4*)(gmlp_g + g * 128 + dc * 8), gb = *(const f32x4*)(gmlp_g + g * 128 + dc * 8 + 4);
                    LAS unsigned short* vt = (LAS unsigned short*)(vnT + (dc * 8) * 272 + s * 2);
                    const unsigned w0 = cvt_pk_bf16((bf_lo(v.x) - mean) * rstd * ga[0], (bf_hi(v.x) - mean) * rstd * ga[1]), w1 = cvt_pk_bf16((bf_lo(v.y) - mean) * rstd * ga[2], (bf_hi(v.y) - mean) * rstd * ga[3]);
                    const unsigned w2 = cvt_pk_bf16((bf_lo(v.z) - mean) * rstd * gb[0], (bf_hi(v.z) - mean) * rstd * gb[1]), w3 = cvt_pk_bf16((bf_lo(v.w) - mean) * rstd * gb[2], (bf_hi(v.w) - mean) * rstd * gb[3]);
                    vt[0 * 136] = (unsigned short)(w0 & 0xffff); vt[1 * 136] = (unsigned short)(w0 >> 16); vt[2 * 136] = (unsigned short)(w1 & 0xffff); vt[3 * 136] = (unsigned short)(w1 >> 16);
                    vt[4 * 136] = (unsigned short)(w2 & 0xffff); vt[5 * 136] = (unsigned short)(w2 >> 16); vt[6 * 136] = (unsigned short)(w3 & 0xffff); vt[7 * 136] = (unsigned short)(w3 >> 16); }
                __syncthreads();
                {
                    const int l15 = lane & 15, quad = lane >> 4;
                    f32x4 acc[8];
#pragma unroll
                    for (int dt = 0; dt < 8; ++dt) acc[dt] = (f32x4){0.f, 0.f, 0.f, 0.f};
                    const int ksmax = wave >> 1;
                    const int t = wave * 16 + l15; const float bias = b_s[g * 128 + t]; const size_t off = (size_t)(R0 + t) * GW + g * 128 + quad * 4;
                    u32x2 uw[8];
#pragma unroll
                    for (int dt = 0; dt < 8; ++dt) uw[dt] = *(const u32x2*)(Ub + off + dt * 16);
#pragma unroll 1
                    for (int ks = 0; ks <= ksmax; ++ks) { const bf16x8 a = *(LAS const bf16x8*)(wsL + (wave * 16 + l15) * 272 + ks * 64 + quad * 16);
#pragma unroll
                        for (int dt = 0; dt < 8; ++dt) { const bf16x8 bb = *(LAS const bf16x8*)(vnT + (dt * 16 + l15) * 272 + ks * 64 + quad * 16);
                            acc[dt] = __builtin_amdgcn_mfma_f32_16x16x32_bf16(bb, a, acc[dt], 0, 0, 0); } }
#pragma unroll
                    for (int dt = 0; dt < 8; ++dt) { u32x2 w; w.x = cvt_pk_bf16(bf_lo(uw[dt].x) * (acc[dt][0] + bias), bf_hi(uw[dt].x) * (acc[dt][1] + bias));
                        w.y = cvt_pk_bf16(bf_lo(uw[dt].y) * (acc[dt][2] + bias), bf_hi(uw[dt].y) * (acc[dt][3] + bias)); *(u32x2*)(GM + off + dt * 16) = w; }
                }
                asm volatile("s_waitcnt lgkmcnt(0)\n\ts_barrier" ::: "memory");
            } else if (it < 1280) {
                const int id = it - 768, b = id >> 2, h = id & 3; ws_g = -1;
                LAS unsigned char* Ks = lds; LAS unsigned char* VT = lds + ATT_VT_OFF;
                const int sl15 = lane & 15, st = sl15 & 7, shead = h * 4 + 2 * (wave & 1) + (sl15 >> 3); const size_t sqoff = (size_t)(NPROMPT + b * 8 + st) * QW + shead * 64;
                const bf16x8 sq0 = *(const bf16x8*)(Qb + sqoff + (lane >> 4) * 8), sq1 = *(const bf16x8*)(Qb + sqoff + 32 + (lane >> 4) * 8);
                { const int key = tid >> 2, part = tid & 3; const float* src = cache_k + ((size_t)(b * 128 + key) * 4 + h) * 64 + part * 16;
                    const f32x4 a0 = *(const f32x4*)src, a1 = *(const f32x4*)(src + 4), a2 = *(const f32x4*)(src + 8), a3 = *(const f32x4*)(src + 12);
                    u32x4 w0, w1; w0.x = cvt_pk_bf16(a0[0], a0[1]); w0.y = cvt_pk_bf16(a0[2], a0[3]); w0.z = cvt_pk_bf16(a1[0], a1[1]); w0.w = cvt_pk_bf16(a1[2], a1[3]);
                    w1.x = cvt_pk_bf16(a2[0], a2[1]); w1.y = cvt_pk_bf16(a2[2], a2[3]); w1.z = cvt_pk_bf16(a3[0], a3[1]); w1.w = cvt_pk_bf16(a3[2], a3[3]);
                    *(LAS u32x4*)(Ks + key * KS_STRIDE + part * 32) = w0; *(LAS u32x4*)(Ks + key * KS_STRIDE + part * 32 + 16) = w1; }
                if (tid < 64) { const int key = 128 + (tid >> 3), chunk = tid & 7; *(LAS u32x4*)(Ks + key * KS_STRIDE + chunk * 16) = *(const u32x4*)(Kb + (size_t)(NPROMPT + b * 8 + (tid >> 3)) * KVW + h * 64 + chunk * 8); }
                else if (tid < 256) { const int key = 136 + ((tid - 64) >> 3), chunk = (tid - 64) & 7; *(LAS u32x4*)(Ks + key * KS_STRIDE + chunk * 16) = (u32x4){0u, 0u, 0u, 0u}; }
                { const int key = tid & 127, part = tid >> 7; const float* src = cache_v + ((size_t)(b * 128 + key) * 4 + h) * 64 + part * 16;
                    LAS unsigned short* vt = (LAS unsigned short*)(VT + (part * 16) * VT_STRIDE + key * 2);
#pragma unroll
                    for (int q4 = 0; q4 < 4; ++q4) { const f32x4 a = *(const f32x4*)(src + 4 * q4); const unsigned w0 = cvt_pk_bf16(a[0], a[1]), w1 = cvt_pk_bf16(a[2], a[3]);
                        vt[(4 * q4 + 0) * (VT_STRIDE / 2)] = (unsigned short)(w0 & 0xffff); vt[(4 * q4 + 1) * (VT_STRIDE / 2)] = (unsigned short)(w0 >> 16);
                        vt[(4 * q4 + 2) * (VT_STRIDE / 2)] = (unsigned short)(w1 & 0xffff); vt[(4 * q4 + 3) * (VT_STRIDE / 2)] = (unsigned short)(w1 >> 16); } }
                if (tid < 64) { const int key = 128 + (tid & 7), chunk = tid >> 3; const u32x4 v = *(const u32x4*)(Vb + (size_t)(NPROMPT + b * 8 + (tid & 7)) * KVW + h * 64 + chunk * 8);
                    LAS unsigned short* vt = (LAS unsigned short*)(VT + (chunk * 8) * VT_STRIDE + key * 2);
                    vt[0 * (VT_STRIDE / 2)] = (unsigned short)(v.x & 0xffff); vt[1 * (VT_STRIDE / 2)] = (unsigned short)(v.x >> 16);
                    vt[2 * (VT_STRIDE / 2)] = (unsigned short)(v.y & 0xffff); vt[3 * (VT_STRIDE / 2)] = (unsigned short)(v.y >> 16);
                    vt[4 * (VT_STRIDE / 2)] = (unsigned short)(v.z & 0xffff); vt[5 * (VT_STRIDE / 2)] = (unsigned short)(v.z >> 16);
                    vt[6 * (VT_STRIDE / 2)] = (unsigned short)(v.w & 0xffff); vt[7 * (VT_STRIDE / 2)] = (unsigned short)(v.w >> 16); }
                for (int idx = tid; idx < 24 * 64; idx += 512) { const int d = idx / 24, key = 136 + idx % 24; *(LAS unsigned short*)(VT + d * VT_STRIDE + key * 2) = 0; }
                __syncthreads();
                if (wave < 2) attn_tile<10>(Ks, VT, sq0, sq1, st, 0, false, sinks[shead] * LOG2E, ATT + sqoff, lane);
                asm volatile("s_waitcnt lgkmcnt(0)\n\ts_barrier" ::: "memory");
            } else {
                const int b = it - 1280, R0 = NPROMPT + b * 8; ws_g = -1;
                LAS float* stat = (LAS float*)lds;
                const int c = 2 * tid, g = wave;
                unsigned gvw[8], uw[8];
#pragma unroll
                for (int s_ = 0; s_ < 8; ++s_) { gvw[s_] = *(const unsigned*)(GVb + (size_t)(R0 + s_) * GW + c); uw[s_] = *(const unsigned*)(Ub + (size_t)(R0 + s_) * GW + c); }
                const f32x2 gam = *(const f32x2*)(gmlp_g + c);
                if (tid < 8) { const float* sp = STG + (size_t)(R0 + tid) * 32; float sm = 0.f, q = 0.f;
#pragma unroll
                    for (int j2 = 0; j2 < 8; ++j2) { const f32x4 v = *(const f32x4*)(sp + 4 * j2); sm += v[0] + v[2]; q += v[1] + v[3]; }
                    const float mean = sm * (1.0f / GW), var = fmaxf(q * (1.0f / GW) - mean * mean, 0.f);
                    stat[2 * tid] = mean; stat[2 * tid + 1] = __builtin_amdgcn_rsqf(var + EPS); }
                __syncthreads();
                float vn0[8], vn1[8];
#pragma unroll
                for (int s_ = 0; s_ < 8; ++s_) { const float mean = stat[2 * s_], rstd = stat[2 * s_ + 1];
                    vn0[s_] = (bf_lo(gvw[s_]) - mean) * rstd * gam[0]; vn1[s_] = (bf_hi(gvw[s_]) - mean) * rstd * gam[1];
                    *(f32x2*)(out + O_SG + (size_t)(b * 8 + s_) * GW + c) = (f32x2){vn0[s_], vn1[s_]}; }
#pragma unroll
                for (int t = 0; t < 8; ++t) { float m0 = b_s[g * 128 + t], m1 = m0;
#pragma unroll
                    for (int s_ = 0; s_ < 8; ++s_) if (s_ <= t) { const float w = w_s[((size_t)g * 128 + t) * 128 + s_]; m0 += w * vn0[s_]; m1 += w * vn1[s_]; }
                    *(unsigned*)(GM + (size_t)(R0 + t) * GW + c) = cvt_pk_bf16(bf_lo(uw[t]) * m0, bf_hi(uw[t]) * m1); }
                asm volatile("s_waitcnt lgkmcnt(0)\n\ts_barrier" ::: "memory");
            }
        }
        {
            const int rank = p1_split ? bx : bx, cnt = p1_split ? p1_tail : G;
            if (!p1_split || bx < p1_tail) { LAS float* scr = (LAS float*)(lds + wave * 16640);
                for (int it = rank * NWAVES + wave; it < 2 * 16 * 32; it += cnt * NWAVES) { const int r = it & 511, kb = r / 32, nb = r % 32;
                    if (it < 512) p0_transpose_item(w_pa, GW, DM, WpaT, 64 * nb, 64 * kb, 64 * nb, scr, lane); else p0_transpose_item(w_pb, QW, DM, WpbT, 64 * nb, 64 * kb, 64 * nb, scr, lane); } }
        }
    }
    SEAM(2);

    if (IN(3)) {
        pg8::Gemm g{GM, WpaT, ATT, WpbT, MROWS, DM, GW}; pg8::DualOrder S; S.b.init(MROWS, DM, GW, G, bx);
        Epi3 E{SAb, SBb, MIX, MIXS};
        pg8::gemm_phase<Epi3, pg8::DualOrder, true>(lds, g, S, E);
        const int rem = S.b.nwg % G, cnt = rem ? G - rem : G, rank = rem ? bx - rem : bx;
        if (rank >= 0) {
            LAS float* scr = (LAS float*)(lds + wave * 16640);
            constexpr int I_O = 32 * 32, I_FF = 32 * 88, NIT = I_O + 2 * I_FF;
            for (int it = rank * NWAVES + wave; it < NIT; it += cnt * NWAVES) {
                int r = it;
                if (r < I_O) { const int kb = r / 32, nb = r % 32; p0_transpose_item(w_o, DM, DM, WoT, 64 * nb, 64 * kb, 64 * nb, scr, lane); continue; } r -= I_O;
                if (r < I_FF) { const int kb = r / 88, nb = r % 88, n0 = 64 * nb; p0_transpose_item(w_ffg, DM, DFF, WguT, 256 * (n0 >> 7) + (n0 & 127), 64 * kb, n0, scr, lane); continue; } r -= I_FF;
                { const int kb = r / 88, nb = r % 88, n0 = 64 * nb; p0_transpose_item(w_ffu, DM, DFF, WguT, 256 * (n0 >> 7) + 128 + (n0 & 127), 64 * kb, n0, scr, lane); }
            }
        }
    }
    SEAM(3);

    if (IN(4)) {
        const bool split45 = (G == 256);
#pragma unroll 1
        for (int sp = 0; sp < 3; ++sp) {
            pg8::Ph45Order S; S.p4p.init(NPROMPT, DM, DM, G, bx); S.p4s.init(NSAMPLE, DM, DM, G, bx); S.p5p.init(NPROMPT, 2 * DFF, DM, G, bx); S.p5s.init(NSAMPLE, 2 * DFF, DM, G, bx);
            S.p4all.init(MROWS, DM, DM, G, bx); S.p5all.init(MROWS, 2 * DFF, DM, G, bx); S.sp = sp; S.split = split45;
            pg8::Gemm g{XG, WguT, (sp == 1 && split45) ? MIXS : MIX, WoT, MROWS, 0, DM};
            Epi45 E{Epi4{x_prompt, x_sample, norm2_g, out + O_Y, XG, SS2}, Epi5{SS2, ACT}};
            pg8::gemm_phase<Epi45, pg8::Ph45Order, true>(lds, g, S, E);
            if (sp == 2) {
                const int rank = split45 ? bx - 112 : bx, cnt = split45 ? 144 : G;
                if (rank >= 0) { LAS float* scr = (LAS float*)(lds + wave * 16640);
                    for (int it = rank * NWAVES + wave; it < 88 * 32; it += cnt * NWAVES) { const int kb = it / 32, nb = it % 32; p0_transpose_item(w_ffd, DFF, DM, WdT, 64 * nb, 64 * kb, 64 * nb, scr, lane); }
                    const int NV = DECB * 120 * 64;
                    for (int i0 = rank * 2048 + tid; i0 < 2 * NV; i0 += cnt * 2048) { f32x4 t[4]; float* dp[4];
#pragma unroll
                        for (int q = 0; q < 4; ++q) { const int i = i0 + q * 512; const int which = i >= NV, r = which ? i - NV : i; const int sb = r / (120 * 64), rem2 = r % (120 * 64);
                            t[q] = __builtin_nontemporal_load((const f32x4*)((which ? cache_v : cache_k) + (size_t)sb * 128 * 256 + 8 * 256 + rem2 * 4));
                            dp[q] = out + (which ? O_SV : O_SK) + (size_t)sb * 128 * 256 + rem2 * 4; }
#pragma unroll
                        for (int q = 0; q < 4; ++q) __builtin_nontemporal_store(t[q], (f32x4*)dp[q]); } }
            }
            if (sp < 2) xcd_barrier(xbar);
        }
    }
    SEAM(5);

    if (IN(6)) {
        const bool split6 = (G == 256);
        int lane6 = threadIdx.x; asm volatile("" : "+v"(lane6)); lane6 &= 63;
        const float* part = (const float*)(ws + WS_PART);
        {
            pg8::Gemm g{ACT, WdT, ACT, WdT, MROWS, DM, DFF}; pg8::SplitTailOrder S; S.p.init(NPROMPT, DM, DFF, G, bx); S.all.init(MROWS, DM, DFF, G, bx); S.pass = 0; S.split = split6;
            Epi6 E{out + O_Y, (float*)(ws + WS_PART)};
            pg8::gemm_phase<Epi6, pg8::SplitTailOrder>(lds, g, S, E);
        }
        xcd_barrier(xbar);
        if (split6 && bx < 128) {
            pg8::Gemm g{ACT, WdT, ACT, WdT, MROWS, DM, DFF}; pg8::SplitTailOrder S; S.p.init(NPROMPT, DM, DFF, G, bx); S.all.init(MROWS, DM, DFF, G, bx); S.pass = 1; S.split = true;
            Epi6 E{out + O_Y, (float*)(ws + WS_PART)};
            pg8::gemm_phase<Epi6, pg8::SplitTailOrder>(lds, g, S, E);
        } else if (split6) {
            for (int m = (bx - 128) * NWAVES + wave; m < NPROMPT; m += 128 * NWAVES) {
                float* yr = out + O_Y + (size_t)m * DM; f32x4 v[8]; float ss = 0.f;
#pragma unroll
                for (int j = 0; j < 8; ++j) { v[j] = __builtin_nontemporal_load((const f32x4*)(yr + (j * 64 + lane6) * 4)); ss += (v[j][0] * v[j][0] + v[j][1] * v[j][1]) + (v[j][2] * v[j][2] + v[j][3] * v[j][3]); }
                const float rstd = __builtin_amdgcn_rsqf(wave_sum(ss) * (1.0f / DM) + EPS);
#pragma unroll
                for (int j = 0; j < 8; ++j) { const f32x4 gg = *(const f32x4*)(final_g + (j * 64 + lane6) * 4); __builtin_nontemporal_store(v[j] * rstd * gg, (f32x4*)(yr + (j * 64 + lane6) * 4)); }
            }
        }
        xcd_barrier(xbar);
        for (int m = (split6 ? NPROMPT : 0) + gw; m < MROWS; m += NGW) {
            float* yr = out + O_Y + (size_t)m * DM; f32x4 v[8]; float ss = 0.f;
#pragma unroll
            for (int j = 0; j < 8; ++j) v[j] = __builtin_nontemporal_load((const f32x4*)(yr + (j * 64 + lane6) * 4));
            if (split6) {
#pragma unroll
                for (int j = 0; j < 8; ++j) { const int tl = j * 4 + ((m >> 8) - 32); if ((j & 1) == 0) asm volatile("" ::: "memory");
#pragma unroll
                    for (int sp = 0; sp < 4; ++sp) v[j] += *(const f32x4*)(part + ((size_t)sp * 32 + tl) * 65536 + (size_t)(m & 255) * 256 + lane6 * 4); } }
#pragma unroll
            for (int j = 0; j < 8; ++j) ss += (v[j][0] * v[j][0] + v[j][1] * v[j][1]) + (v[j][2] * v[j][2] + v[j][3] * v[j][3]);
            const float rstd = __builtin_amdgcn_rsqf(wave_sum(ss) * (1.0f / DM) + EPS);
#pragma unroll
            for (int j = 0; j < 8; ++j) { const f32x4 gg = *(const f32x4*)(final_g + (j * 64 + lane6) * 4); __builtin_nontemporal_store(v[j] * rstd * gg, (f32x4*)(yr + (j * 64 + lane6) * 4)); }
        }
    }
#undef IN
#undef SEAM
}

extern "C" void kernel_launch(void* const* d_in, const int* in_sizes, int n_in, void* d_out, int out_size, void* d_ws, size_t ws_size, hipStream_t stream) {
    static int grid_blocks = 0;
    if (grid_blocks == 0) {
        if (n_in != 18 || ws_size < WS_END) { fprintf(stderr, "kernel_launch: expected 18 inputs and >= %zu bytes of workspace (got %d, %zu)\n", (size_t)WS_END, n_in, ws_size); grid_blocks = -1; return; }
        int dev = 0, cus = 0, per_cu = 0;
        hipGetDevice(&dev);
        hipDeviceGetAttribute(&cus, hipDeviceAttributeMultiprocessorCount, dev);
        if (hipFuncSetAttribute((const void*)fwd_megakernel, hipFuncAttributeMaxDynamicSharedMemorySize, LDS_BYTES) != hipSuccess) { fprintf(stderr, "kernel_launch: hipFuncSetAttribute failed\n"); grid_blocks = -1; return; }
        if (hipOccupancyMaxActiveBlocksPerMultiprocessor(&per_cu, (const void*)fwd_megakernel, NWAVES * 64, LDS_BYTES) != hipSuccess || per_cu < 1) { fprintf(stderr, "kernel_launch: occupancy query reports %d blocks per CU\n", per_cu); per_cu = 1; (void)hipGetLastError(); }
        grid_blocks = cus * (per_cu > 1 ? 1 : per_cu);
    }
    if (grid_blocks < 0) return;
    Args a{};
    for (int i = 0; i < 18; ++i) a.in[i] = (const float*)d_in[i];
    a.out = (float*)d_out; a.ws = (unsigned char*)d_ws;
    a.ph_lo = 0; a.ph_hi = 8;
    if (hipMemsetAsync(d_ws, 0, 16384, stream) != hipSuccess) { fprintf(stderr, "kernel_launch: hipMemsetAsync of the barrier words failed\n"); return; }
    void* kargs[] = {&a};
    hipError_t e = hipLaunchCooperativeKernel((const void*)fwd_megakernel, dim3(grid_blocks), dim3(NWAVES * 64), kargs, LDS_BYTES, stream);
    if (e != hipSuccess) fprintf(stderr, "kernel_launch: cooperative launch failed: %s (grid %d)\n", hipGetErrorString(e), grid_blocks);
}
```
